# Optimizing an MI355X kernel written in HIP

```python
import math
import jax, jax.numpy as jnp
from jax import lax
import numpy as np

D_MODEL = 1024
BATCH = 8
SEQ = 2048
DEPTH = 1
DEC_BATCH = 2
DEC_SEQ = 16384
PAST_LEN = 128

CONV_WIDTH = D_MODEL // 2
CONV_GROUPS = 8
CONV_TAPS = 3
N_HEADS = 8
QK_NOPE_DIM = 64
QK_ROPE_DIM = 32
V_HEAD_DIM = 64
ATTN_WIDTH = N_HEADS * V_HEAD_DIM
Q_LORA_RANK = 384
KV_LORA_RANK = 256
MIX_WIDTH = CONV_WIDTH + ATTN_WIDTH
ROPE_THETA = 10000.0
Q_BLOCK = 128
NORM_EPS = 1e-6
SPLIT_SIZES = (CONV_WIDTH, CONV_WIDTH, CONV_WIDTH, CONV_WIDTH,
               Q_LORA_RANK, KV_LORA_RANK, QK_ROPE_DIM, ATTN_WIDTH)
IN_WIDTH = 4 * CONV_WIDTH + Q_LORA_RANK + KV_LORA_RANK + QK_ROPE_DIM + ATTN_WIDTH

kernel_name = "hymba_shortconv_mla_sandwich_encoder"


def _rmsnorm(x, g):
    xf = x.astype(jnp.float32)
    y = xf * lax.rsqrt(jnp.mean(xf * xf, axis=-1, keepdims=True) + NORM_EPS)
    return (y * g.astype(jnp.float32)).astype(x.dtype)


def _split_points():
    pts, acc = [], 0
    for s in SPLIT_SIZES[:-1]:
        acc += s
        pts.append(acc)
    return pts


def _rope_tables(seq_len, dtype):
    freqs = 1.0 / (ROPE_THETA ** (jnp.arange(0, QK_ROPE_DIM, 2, dtype=jnp.float32) / QK_ROPE_DIM))
    ang = jnp.arange(seq_len, dtype=jnp.float32)[:, None] * freqs[None, :]
    return jnp.cos(ang).astype(dtype), jnp.sin(ang).astype(dtype)


def _apply_rope(x, cos, sin):
    x1, x2 = jnp.split(x, 2, axis=-1)
    return jnp.concatenate([x1 * cos - x2 * sin, x2 * cos + x1 * sin], axis=-1)


def _short_conv(u, w):
    up = jnp.pad(u, ((0, 0), (1, 1), (0, 0)))
    return up[:, :-2] * w[0] + up[:, 1:-1] * w[1] + up[:, 2:] * w[2]


def _attention(q, k, v):
    b, s, h, dqk = q.shape
    dv = v.shape[-1]
    nblk = s // Q_BLOCK
    scale = 1.0 / math.sqrt(dqk)
    qb = q.reshape(b, nblk, Q_BLOCK, h, dqk).transpose(1, 0, 2, 3, 4)

    def one_block(qblk):
        sc = jnp.einsum('bqhd,bkhd->bhqk', qblk, k, preferred_element_type=jnp.float32) * scale
        p = jax.nn.softmax(sc, axis=-1)
        return jnp.einsum('bhqk,bkhd->bqhd', p.astype(v.dtype), v)

    o = lax.map(one_block, qb)
    return o.transpose(1, 0, 2, 3, 4).reshape(b, s, h * dv)


def _layer(x, norm_pre, w_in, conv_w, q_norm, w_uq, kv_norm, w_ukv, w_out, norm_post):
    b, s, _ = x.shape
    hdn = _rmsnorm(x, norm_pre)
    proj = jnp.einsum('bsd,de->bse', hdn, w_in)
    u, b_gate, c_gate, z_conv, q_lat, kv_lat, k_pe, z_attn = jnp.split(proj, _split_points(), axis=-1)

    conv_out = b_gate * _short_conv(c_gate * u, conv_w) * jax.nn.silu(z_conv)

    cos, sin = _rope_tables(s, x.dtype)
    q = jnp.einsum('bsr,re->bse', _rmsnorm(q_lat, q_norm), w_uq).reshape(
        b, s, N_HEADS, QK_NOPE_DIM + QK_ROPE_DIM)
    q_nope, q_pe = jnp.split(q, [QK_NOPE_DIM], axis=-1)
    q_pe = _apply_rope(q_pe, cos[:, None, :], sin[:, None, :])
    kv = jnp.einsum('bsr,re->bse', _rmsnorm(kv_lat, kv_norm), w_ukv).reshape(
        b, s, N_HEADS, QK_NOPE_DIM + V_HEAD_DIM)
    k_nope, v = jnp.split(kv, [QK_NOPE_DIM], axis=-1)
    k_pe = _apply_rope(k_pe, cos, sin)
    k_pe = jnp.broadcast_to(k_pe[:, :, None, :], (b, s, N_HEADS, QK_ROPE_DIM))
    q_full = jnp.concatenate([q_nope, q_pe], axis=-1)
    k_full = jnp.concatenate([k_nope, k_pe], axis=-1)
    attn_out = _attention(q_full, k_full, v) * jax.nn.silu(z_attn)

    mix = jnp.concatenate([conv_out, attn_out], axis=-1)
    out = jnp.einsum('bse,ed->bsd', mix, w_out)
    return x + _rmsnorm(out, norm_post)


def setup_inputs(seed: int = 0) -> dict:
    key = jax.random.key(seed)
    ks = jax.random.split(key, 12)
    f32 = jnp.float32
    nrm = lambda k, shp, scale: (jax.random.normal(k, shp, f32) * scale)
    return {
        "x_prompt": nrm(ks[0], (BATCH, SEQ, D_MODEL), 1.0),
        "x_sample": nrm(ks[1], (DEC_BATCH, DEC_SEQ, D_MODEL), 1.0),
        "norm_pre": 1.0 + nrm(ks[2], (DEPTH, D_MODEL), 0.02),
        "w_in": nrm(ks[3], (DEPTH, D_MODEL, IN_WIDTH), D_MODEL ** -0.5),
        "conv_w": nrm(ks[4], (DEPTH, CONV_TAPS, CONV_WIDTH), CONV_TAPS ** -0.5),
        "q_norm": 1.0 + nrm(ks[5], (DEPTH, Q_LORA_RANK), 0.02),
        "w_uq": nrm(ks[6], (DEPTH, Q_LORA_RANK, N_HEADS * (QK_NOPE_DIM + QK_ROPE_DIM)), Q_LORA_RANK ** -0.5),
        "kv_norm": 1.0 + nrm(ks[7], (DEPTH, KV_LORA_RANK), 0.02),
        "w_ukv": nrm(ks[8], (DEPTH, KV_LORA_RANK, N_HEADS * (QK_NOPE_DIM + V_HEAD_DIM)), KV_LORA_RANK ** -0.5),
        "w_out": nrm(ks[9], (DEPTH, MIX_WIDTH, D_MODEL), MIX_WIDTH ** -0.5),
        "norm_post": 1.0 + nrm(ks[10], (DEPTH, D_MODEL), 0.02),
    }


def reference(x_prompt, x_sample, norm_pre, w_in, conv_w, q_norm, w_uq, kv_norm, w_ukv, w_out, norm_post):
    y_prompt = x_prompt
    y_sample = x_sample
    for l in range(DEPTH):
        y_prompt = _layer(y_prompt, norm_pre[l], w_in[l], conv_w[l], q_norm[l], w_uq[l],
                          kv_norm[l], w_ukv[l], w_out[l], norm_post[l])
        y_sample = _layer(y_sample, norm_pre[l], w_in[l], conv_w[l], q_norm[l], w_uq[l],
                          kv_norm[l], w_ukv[l], w_out[l], norm_post[l])
    return (y_prompt, y_sample)
```

```cpp
#include <hip/hip_runtime.h>
#include <hip/hip_cooperative_groups.h>
#include <cstdio>
#include <cstdint>
namespace cg = cooperative_groups;

typedef unsigned short bf16_t;
typedef short bf16x8 __attribute__((ext_vector_type(8)));
typedef float f32x16 __attribute__((ext_vector_type(16)));
typedef float f32x4 __attribute__((ext_vector_type(4)));
typedef float f32x2 __attribute__((ext_vector_type(2)));
typedef unsigned u32x4 __attribute__((ext_vector_type(4)));
typedef unsigned u32x2 __attribute__((ext_vector_type(2)));
#define LAS __attribute__((address_space(3)))

constexpr int DM = 1024, NTOK = 49152, NTOK_P = 16384, SEQ_P = 2048, SEQ_S = 16384;
constexpr int CW = 512, NH = 8, QLR = 384, KVLR = 256, ROPE = 32, AW = 512;
constexpr int NIN = 3328;
constexpr int NBLK32 = NTOK / 32;
constexpr float EPS = 1e-6f;
constexpr float C2 = 0.14724444f;

constexpr size_t MiB = 1u << 20;
constexpr size_t WS_SSQ = 0;
constexpr size_t WS_COS = 1 * MiB, WS_SIN = 2 * MiB;
constexpr size_t WS_WIN = 3 * MiB;
constexpr size_t WS_WUQ = 10 * MiB;
constexpr size_t WS_WUKV = 11 * MiB;
constexpr size_t WS_WOUT = 12 * MiB;
constexpr size_t WS_XN = 16 * MiB;
constexpr size_t WS_QF = 16 * MiB;
constexpr size_t WS_CU = 112 * MiB;
constexpr size_t WS_GZ = 160 * MiB;
constexpr size_t WS_SZ = 208 * MiB;
constexpr size_t WS_QLAT = 256 * MiB;
constexpr size_t WS_KVLAT = 292 * MiB;
constexpr size_t WS_MIX2 = 256 * MiB;
constexpr size_t WS_KF = 316 * MiB;
constexpr size_t WS_VF = 388 * MiB;
constexpr size_t WS_MIXA = 436 * MiB;
constexpr size_t WS_END = 484 * MiB;

constexpr int LDS_BYTES = 131072;
constexpr int NTHR = 512;

struct Params {
    const float* x_prompt; const float* x_sample; const float* norm_pre; const float* w_in; const float* conv_w;
    const float* q_norm; const float* w_uq; const float* kv_norm; const float* w_ukv; const float* w_out; const float* norm_post;
    float* out; unsigned char* ws;
};

__device__ __forceinline__ unsigned pk_bf16(float lo, float hi) {
    typedef __bf16 b2 __attribute__((ext_vector_type(2)));
    f32x2 v = {lo, hi}; b2 b = __builtin_convertvector(v, b2); return __builtin_bit_cast(unsigned, b);
}
__device__ __forceinline__ float bf_lo(unsigned u) { return __uint_as_float(u << 16); }
__device__ __forceinline__ float bf_hi(unsigned u) { return __uint_as_float(u & 0xffff0000u); }
__device__ __forceinline__ u32x4 pack8(const float* v) {
    u32x4 w; w.x = pk_bf16(v[0], v[1]); w.y = pk_bf16(v[2], v[3]); w.z = pk_bf16(v[4], v[5]); w.w = pk_bf16(v[6], v[7]); return w;
}
typedef int i32x8 __attribute__((ext_vector_type(8)));
__device__ __forceinline__ u32x4 pack16_fp8(const float* v) {
    u32x4 w;
#pragma unroll
    for (int k = 0; k < 4; ++k) { int t = __builtin_amdgcn_cvt_pk_fp8_f32(v[4 * k], v[4 * k + 1], 0, false); t = __builtin_amdgcn_cvt_pk_fp8_f32(v[4 * k + 2], v[4 * k + 3], t, true); w[k] = (unsigned)t; }
    return w;
}
__device__ __forceinline__ f32x16 mfma8(u32x4 a0, u32x4 a1, u32x4 b0, u32x4 b1, f32x16 c) {
    const i32x8 A = {(int)a0.x, (int)a0.y, (int)a0.z, (int)a0.w, (int)a1.x, (int)a1.y, (int)a1.z, (int)a1.w};
    const i32x8 B = {(int)b0.x, (int)b0.y, (int)b0.z, (int)b0.w, (int)b1.x, (int)b1.y, (int)b1.z, (int)b1.w};
    return __builtin_amdgcn_mfma_scale_f32_32x32x64_f8f6f4(A, B, c, 0, 0, 0, 0x7f7f7f7f, 0, 0x7f7f7f7f);
}
__device__ __forceinline__ float silu_f(float z) { return z * __builtin_amdgcn_rcpf(1.f + __builtin_amdgcn_exp2f(-1.4426950408889634f * z)); }
__device__ __forceinline__ int cperm(int p) { const int hp = (p >> 2) & 1, r = (p & 3) + 4 * (p >> 3); return 16 * (r >> 3) + 8 * hp + (r & 7); }
__device__ __forceinline__ int crow(int r, int hi) { return (r & 3) + 8 * (r >> 2) + 4 * hi; }
__device__ __forceinline__ float swap32_max(float m) {
    auto rr = __builtin_amdgcn_permlane32_swap(__float_as_uint(m), __float_as_uint(m), false, false);
    return fmaxf(__uint_as_float(rr[0]), __uint_as_float(rr[1]));
}
__device__ __forceinline__ float swap32_sum(float m) {
    auto rr = __builtin_amdgcn_permlane32_swap(__float_as_uint(m), __float_as_uint(m), false, false);
    return __uint_as_float(rr[0]) + __uint_as_float(rr[1]);
}
__device__ __forceinline__ float wave_sum(float v) {
#pragma unroll
    for (int o = 1; o < 64; o <<= 1) v += __shfl_xor(v, o);
    return v;
}
__device__ __forceinline__ const float* xrow(const Params& p, int tok) {
    return tok < NTOK_P ? p.x_prompt + (size_t)tok * DM : p.x_sample + (size_t)(tok - NTOK_P) * DM;
}
__device__ __forceinline__ int tok_pos(int tok) { return tok < NTOK_P ? (tok & (SEQ_P - 1)) : (tok & (SEQ_S - 1)); }

__device__ __forceinline__ void glds16(const void* gsrc, unsigned lds_dst) {
    unsigned keep;
    asm volatile("s_mov_b32 %0, m0\n\ts_mov_b32 m0, %2\n\ts_nop 0\n\tglobal_load_lds_dwordx4 %1, off\n\ts_mov_b32 m0, %0" : "=&s"(keep) : "v"(gsrc), "s"(lds_dst) : "memory");
}
#define AT_WAIT_BAR(N) asm volatile("s_waitcnt vmcnt(" #N ") lgkmcnt(0)\n\ts_barrier" ::: "memory")

__device__ __forceinline__ int win_src(int np) {
    const int T = np >> 7, w = np & 127;
    if (T < 16) { const int wn = w >> 6, j = (w >> 5) & 1, q = (w >> 4) & 1, i16 = w & 15; return (2 * j + q) * 512 + 32 * T + 16 * wn + i16; }
    if (T < 21) return np;
    if (T < 25) return 2720 + (np - 2688);
    return w < 32 ? 2688 + w : -1;
}
template <int MODE>
__device__ __forceinline__ void prep_weight(const float* __restrict__ w, const float* __restrict__ gain, bf16_t* WT, int K, int Nsrc, int Ndst, int gtid, int gthreads) {
    const int items = Ndst * (K / 8);
    for (int id = gtid; id < items; id += gthreads) {
        const int n = id % Ndst, kc = id / Ndst, k0 = kc * 8;
        const int src = (MODE == 1) ? win_src(n) : n;
        float v[8];
#pragma unroll
        for (int e = 0; e < 8; ++e) v[e] = (src >= 0) ? w[(size_t)(k0 + e) * Nsrc + src] * (gain ? gain[k0 + e] : 1.f) : 0.f;
        *(u32x4*)(WT + (size_t)n * K + k0) = pack8(v);
    }
}
__device__ __forceinline__ void rope_entry(int pos, int i, float& c, float& s) {
    const int a = i & 3, b = i >> 2;
    double base = a == 0 ? 1.0 : a == 1 ? 0.5623413251903491 : a == 2 ? 0.31622776601683794 : 0.1778279410038923;
    double sc = b == 0 ? 1.0 : b == 1 ? 0.1 : b == 2 ? 0.01 : 0.001;
    const float freq = (float)(base * sc);
    const float angf = (float)pos * freq;
    const double x = (double)angf;
    const double kq = rint(x * 0.6366197723675814);
    const double r = (x - kq * 1.5707963267948966) - kq * 6.123233995736766e-17;
    const double r2 = r * r;
    const double sn = r * (1.0 + r2 * (-1.0 / 6 + r2 * (1.0 / 120 + r2 * (-1.0 / 5040 + r2 * (1.0 / 362880 + r2 * (-1.0 / 39916800))))));
    const double cs = 1.0 + r2 * (-0.5 + r2 * (1.0 / 24 + r2 * (-1.0 / 720 + r2 * (1.0 / 40320 + r2 * (-1.0 / 3628800 + r2 * (1.0 / 479001600))))));
    const int qd = ((int)kq) & 3;
    const double so = qd == 0 ? sn : qd == 1 ? cs : qd == 2 ? -sn : -cs;
    const double co = qd == 0 ? cs : qd == 1 ? -sn : qd == 2 ? -cs : sn;
    c = (float)co; s = (float)so;
}
__device__ __forceinline__ void phase0(const Params& p, int gtid, int gthreads) {
    unsigned char* ws = p.ws;
    float* ssq = (float*)(ws + WS_SSQ);
    for (int i = gtid; i < 3 * NTOK; i += gthreads) ssq[i] = 0.f;
    float* ct = (float*)(ws + WS_COS); float* st = (float*)(ws + WS_SIN);
    for (int i = gtid; i < SEQ_S * 16; i += gthreads) { float c, s; rope_entry(i >> 4, i & 15, c, s); ct[i] = c; st[i] = s; }
    prep_weight<1>(p.w_in, p.norm_pre, (bf16_t*)(ws + WS_WIN), DM, 3232, NIN, gtid, gthreads);
    prep_weight<0>(p.w_uq, p.q_norm, (bf16_t*)(ws + WS_WUQ), QLR, 768, 768, gtid, gthreads);
    prep_weight<0>(p.w_ukv, p.kv_norm, (bf16_t*)(ws + WS_WUKV), KVLR, 1024, 1024, gtid, gthreads);
    prep_weight<0>(p.w_out, nullptr, (bf16_t*)(ws + WS_WOUT), DM, 1024, 1024, gtid, gthreads);
    const int gw = gtid >> 6, nw = gthreads >> 6, lane = threadIdx.x & 63;
    bf16_t* xn = (bf16_t*)(ws + WS_XN);
    for (int row = gw * 2; row < NTOK; row += nw * 2) {
        f32x4 v[2][4]; float s[2];
#pragma unroll
        for (int u = 0; u < 2; ++u) {
            const f32x4* xr = (const f32x4*)xrow(p, row + u) + lane; s[u] = 0.f;
#pragma unroll
            for (int j = 0; j < 4; ++j) { v[u][j] = xr[64 * j]; }
        }
#pragma unroll
        for (int u = 0; u < 2; ++u) {
#pragma unroll
            for (int j = 0; j < 4; ++j) s[u] += (v[u][j].x * v[u][j].x + v[u][j].y * v[u][j].y) + (v[u][j].z * v[u][j].z + v[u][j].w * v[u][j].w);
            const float rs = rsqrtf(wave_sum(s[u]) * (1.f / DM) + EPS);
            u32x2* o = (u32x2*)(xn + (size_t)(row + u) * DM) + lane;
#pragma unroll
            for (int j = 0; j < 4; ++j) { u32x2 w; w.x = pk_bf16(v[u][j].x * rs, v[u][j].y * rs); w.y = pk_bf16(v[u][j].z * rs, v[u][j].w * rs); o[64 * j] = w; }
        }
    }
}

__device__ __forceinline__ void tile_map(int w, int NT, int xcd, int MPX, int& mt, int& nt) {
    const int g = w / (8 * NT), rem = w % (8 * NT);
    nt = rem >> 3; mt = xcd * MPX + g * 8 + (rem & 7);
}
template <int MI, int NJ, int MODE, class Epi>
__device__ __forceinline__ void gemm_dma(unsigned char* lds, const bf16_t* __restrict__ A0, const bf16_t* __restrict__ A1, int ksplit, int lda,
                                         const bf16_t* __restrict__ Bt, int K, int NT, int xcd, int lb, int GX, const Epi& epi) {
    constexpr int NSA = 4 * MI, NSUB = 4 * MI + 8 * NJ, STAGE = NSUB * 1024, NIT = NSUB / 8, NITA = NSA / 8, BOFF = NSA * 1024, MPX = 96 / MI;
    static_assert(4 * STAGE <= LDS_BYTES && NSUB % 8 == 0 && NSA % 8 == 0, "lds");
    const int tid = threadIdx.x, lane = tid & 63, wid = __builtin_amdgcn_readfirstlane(tid >> 6), wm = wid >> 2, wn = wid & 3;
    const int r32 = lane & 31, hi = lane >> 5;
    const unsigned lds0 = (unsigned)(uintptr_t)lds;
    const int nk = K / 32, count = MPX * NT;
    int w = lb;
    if (w >= count) return;
    int mt, nt; tile_map(w, NT, xcd, MPX, mt, nt);
    const int rowl = lane >> 2, colsw = 8 * ((lane & 3) ^ ((lane >> 4) & 3));
    const size_t aoffs = (size_t)rowl * lda + colsw, boffs = (size_t)rowl * K + colsw;
    auto dma = [&](int tmt, int tnt, int kt, int stage) {
        const int k0 = kt * 32;
        const bf16_t* Ab = ((k0 < ksplit) ? A0 + k0 : A1 + (k0 - ksplit)) + (size_t)(tmt * 64 * MI) * lda + aoffs;
        const bf16_t* Bb = Bt + (size_t)(tnt * 128 * NJ) * K + k0 + boffs;
#pragma unroll
        for (int it = 0; it < NIT; ++it) {
            const int f = wid + 8 * it;
            const bf16_t* src = (it < NITA) ? Ab + (size_t)(f * 16) * lda : Bb + (size_t)((f - NSA) * 16) * K;
            glds16(src, (unsigned)__builtin_amdgcn_readfirstlane((int)(lds0 + stage * STAGE + f * 1024)));
        }
    };
    const int cb = cperm(r32);
    const int arow = (wm * 32 * MI + r32), brow = (wn * 32 * NJ + cb);
    const int abase = (arow >> 4) * 1024 + (arow & 15) * 64, ax = (arow >> 2) & 3;
    const int bbase = BOFF + (brow >> 4) * 1024 + (brow & 15) * 64, bx_ = (brow >> 2) & 3;
    const bool swp = (MODE == 0) || ((wn & 1) == 0);
    f32x16 acc[MI][NJ];
    auto compute = [&](int stage) {
        const unsigned char* base = lds + stage * STAGE;
#pragma unroll
        for (int kk = 0; kk < 2; ++kk) {
            bf16x8 af[MI], bfr[NJ];
            const int ca = ((2 * kk + hi) ^ ax) << 4, cbb = ((2 * kk + hi) ^ bx_) << 4;
#pragma unroll
            for (int i = 0; i < MI; ++i) af[i] = *(const bf16x8*)(base + abase + i * 2048 + ca);
#pragma unroll
            for (int j = 0; j < NJ; ++j) bfr[j] = *(const bf16x8*)(base + bbase + j * 2048 + cbb);
#pragma unroll
            for (int i = 0; i < MI; ++i)
#pragma unroll
                for (int j = 0; j < NJ; ++j) {
                    if (MODE == 0) acc[i][j] = __builtin_amdgcn_mfma_f32_32x32x16_bf16(bfr[j], af[i], acc[i][j], 0, 0, 0);
                    else { const bf16x8 xa = swp ? bfr[j] : af[i], xb = swp ? af[i] : bfr[j]; acc[i][j] = __builtin_amdgcn_mfma_f32_32x32x16_bf16(xa, xb, acc[i][j], 0, 0, 0); }
                }
        }
    };
    auto dma2 = [&](int tmt, int tnt, int kt2, int sb) { dma(tmt, tnt, 2 * kt2, 2 * sb); dma(tmt, tnt, 2 * kt2 + 1, 2 * sb + 1); };
    dma2(mt, nt, 0, 0);
    int sb = 0;
    const int nk2 = nk >> 1;
    for (;;) {
        const int wnx = w + GX; const bool has_next = wnx < count;
        int mt2 = mt, nt2 = nt; if (has_next) tile_map(wnx, NT, xcd, MPX, mt2, nt2);
#pragma unroll
        for (int i = 0; i < MI; ++i)
#pragma unroll
            for (int j = 0; j < NJ; ++j)
#pragma unroll
                for (int r = 0; r < 16; ++r) acc[i][j][r] = 0.f;
        AT_WAIT_BAR(0);
        for (int kt2 = 0; kt2 < nk2; ++kt2) {
            const bool last = kt2 + 1 == nk2;
            if (wm == 0) { if (!last) dma2(mt, nt, kt2 + 1, sb ^ 1); else if (has_next) dma2(mt2, nt2, 0, sb ^ 1); }
            compute(2 * sb);
            if (wm != 0) { if (!last) dma2(mt, nt, kt2 + 1, sb ^ 1); else if (has_next) dma2(mt2, nt2, 0, sb ^ 1); }
            compute(2 * sb + 1);
            if (!last) AT_WAIT_BAR(0);
            sb ^= 1;
        }
        epi(acc, mt, nt * 2 + (wn >> 1), wm, wn & 1, r32, hi);
        if (!has_next) break;
        w = wnx; mt = mt2; nt = nt2;
    }
    AT_WAIT_BAR(0);
}

struct EpiIn {
    unsigned char* ws;
    template <int MI> __device__ __forceinline__ void operator()(f32x16 (&acc)[MI][2], int mt, int nt, int wm, int wn, int r32, int hi) const {
        const int lane = r32 + 32 * hi;
        if (nt < 16) {
            bf16_t* cu = (bf16_t*)(ws + WS_CU); bf16_t* gz = (bf16_t*)(ws + WS_GZ);
#pragma unroll
            for (int i = 0; i < MI; ++i) {
                const int tok = mt * (64 * MI) + wm * (32 * MI) + 32 * i + r32; const int ch0 = 32 * nt + 16 * wn + 8 * hi;
                float a[8], b[8];
#pragma unroll
                for (int e = 0; e < 8; ++e) { const float u = acc[i][0][e], B = acc[i][0][8 + e], C = acc[i][1][e], z = acc[i][1][8 + e]; a[e] = C * u; b[e] = B * silu_f(z); }
                *(u32x4*)(cu + (size_t)tok * CW + ch0) = pack8(a);
                *(u32x4*)(gz + (size_t)tok * CW + ch0) = pack8(b);
            }
        } else if (nt < 21) {
            const bool isq = nt < 19;
            bf16_t* dst = (bf16_t*)(ws + (isq ? WS_QLAT : WS_KVLAT)); const int ld = isq ? QLR : KVLR; const int cb = (isq ? (nt - 16) : (nt - 19)) * 128 + wn * 64 + 8 * hi;
            float* ssq = (float*)(ws + WS_SSQ) + (isq ? 0 : NTOK);
#pragma unroll
            for (int i = 0; i < MI; ++i) {
                const int tok = mt * (64 * MI) + wm * (32 * MI) + 32 * i + r32; float ss = 0.f;
#pragma unroll
                for (int j = 0; j < 2; ++j)
#pragma unroll
                    for (int q = 0; q < 2; ++q) {
                        float v[8];
#pragma unroll
                        for (int e = 0; e < 8; ++e) { v[e] = acc[i][j][8 * q + e]; ss += v[e] * v[e]; }
                        *(u32x4*)(dst + (size_t)tok * ld + cb + 32 * j + 16 * q) = pack8(v);
                    }
                ss = swap32_sum(ss);
                if (hi == 0) atomicAdd(ssq + tok, ss);
            }
        } else if (nt < 25) {
            bf16_t* sz = (bf16_t*)(ws + WS_SZ); const int cb = (nt - 21) * 128 + wn * 64 + 8 * hi;
#pragma unroll
            for (int i = 0; i < MI; ++i) {
                const int tok = mt * (64 * MI) + wm * (32 * MI) + 32 * i + r32;
#pragma unroll
                for (int j = 0; j < 2; ++j)
#pragma unroll
                    for (int q = 0; q < 2; ++q) {
                        float v[8];
#pragma unroll
                        for (int e = 0; e < 8; ++e) v[e] = silu_f(acc[i][j][8 * q + e]);
                        *(u32x4*)(sz + (size_t)tok * AW + cb + 32 * j + 16 * q) = pack8(v);
                    }
            }
        } else if (wn == 0) {
            const float* ct = (const float*)(ws + WS_COS); const float* st = (const float*)(ws + WS_SIN);
            unsigned char* kf = ws + WS_KF;
#pragma unroll
            for (int i = 0; i < MI; ++i) {
                const int tok = mt * (64 * MI) + wm * (32 * MI) + 32 * i + r32; const int pos = tok_pos(tok);
                const f32x4 c0 = *(const f32x4*)(ct + pos * 16 + 8 * hi), c1 = *(const f32x4*)(ct + pos * 16 + 8 * hi + 4);
                const f32x4 s0 = *(const f32x4*)(st + pos * 16 + 8 * hi), s1 = *(const f32x4*)(st + pos * 16 + 8 * hi + 4);
                float o[16];
#pragma unroll
                for (int e = 0; e < 8; ++e) { const float c = e < 4 ? c0[e & 3] : c1[e & 3], s = e < 4 ? s0[e & 3] : s1[e & 3]; const float x1 = acc[i][0][e], x2 = acc[i][0][8 + e]; o[e] = x1 * c - x2 * s; o[8 + e] = x2 * c + x1 * s; }
                const u32x4 w1 = pack16_fp8(o); const int blk = tok >> 5;
#pragma unroll
                for (int h = 0; h < NH; ++h) *(u32x4*)(kf + ((size_t)(h * NBLK32 + blk) * 3 + 2) * 1024 + lane * 16) = w1;
            }
        }
    }
};
struct EpiQ {
    unsigned char* ws;
    template <int MI> __device__ __forceinline__ void operator()(f32x16 (&acc)[MI][3], int mt, int nt, int wm, int wn, int r32, int hi) const {
        const int lane = r32 + 32 * hi, head = nt * 2 + wn;
        const float* ssq = (const float*)(ws + WS_SSQ);
        const float* ct = (const float*)(ws + WS_COS); const float* st = (const float*)(ws + WS_SIN);
#pragma unroll
        for (int i = 0; i < MI; ++i) {
            const int tok = mt * (64 * MI) + wm * (32 * MI) + 32 * i + r32; const int pos = tok_pos(tok);
            const float rs = rsqrtf(__hip_atomic_load(ssq + tok, __ATOMIC_RELAXED, __HIP_MEMORY_SCOPE_AGENT) * (1.f / QLR) + EPS) * C2;
            unsigned char* d = ws + WS_QF + ((size_t)(head * NBLK32 + (tok >> 5)) * 3) * 1024 + lane * 16;
#pragma unroll
            for (int j = 0; j < 2; ++j) {
                float v[16];
#pragma unroll
                for (int r = 0; r < 16; ++r) v[r] = acc[i][j][r] * rs;
                *(u32x4*)(d + j * 1024) = pack16_fp8(v);
            }
            const f32x4 c0 = *(const f32x4*)(ct + pos * 16 + 8 * hi), c1 = *(const f32x4*)(ct + pos * 16 + 8 * hi + 4);
            const f32x4 s0 = *(const f32x4*)(st + pos * 16 + 8 * hi), s1 = *(const f32x4*)(st + pos * 16 + 8 * hi + 4);
            float o[16];
#pragma unroll
            for (int e = 0; e < 8; ++e) { const float c = e < 4 ? c0[e & 3] : c1[e & 3], s = e < 4 ? s0[e & 3] : s1[e & 3]; const float x1 = acc[i][2][e] * rs, x2 = acc[i][2][8 + e] * rs; o[e] = x1 * c - x2 * s; o[8 + e] = x2 * c + x1 * s; }
            *(u32x4*)(d + 2 * 1024) = pack16_fp8(o);
        }
    }
};
struct EpiKV {
    unsigned char* ws;
    template <int MI> __device__ __forceinline__ void operator()(f32x16 (&acc)[MI][2], int mt, int nt, int wm, int wn, int r32, int hi) const {
        static_assert(MI % 2 == 0, "V fragments pair two 32-token blocks");
        const int lane = r32 + 32 * hi, head = nt;
        const float* ssq = (const float*)(ws + WS_SSQ) + NTOK;
        if (wn == 0) {
#pragma unroll
            for (int i = 0; i < MI; ++i) {
                const int tok = mt * (64 * MI) + wm * (32 * MI) + 32 * i + r32;
                const float rs = rsqrtf(__hip_atomic_load(ssq + tok, __ATOMIC_RELAXED, __HIP_MEMORY_SCOPE_AGENT) * (1.f / KVLR) + EPS);
                unsigned char* d = ws + WS_KF + ((size_t)(head * NBLK32 + (tok >> 5)) * 3) * 1024 + lane * 16;
#pragma unroll
                for (int j = 0; j < 2; ++j) {
                    float v[16];
#pragma unroll
                    for (int r = 0; r < 16; ++r) v[r] = acc[i][j][r] * rs;
                    *(u32x4*)(d + j * 1024) = pack16_fp8(v);
                }
            }
        } else {
#pragma unroll
            for (int i = 0; i < MI; ++i) {
                const int tb = mt * (64 * MI) + wm * (32 * MI) + 32 * i;
                float rs[16];
#pragma unroll
                for (int r = 0; r < 16; ++r) rs[r] = rsqrtf(__hip_atomic_load(ssq + tb + crow(r, hi), __ATOMIC_RELAXED, __HIP_MEMORY_SCOPE_AGENT) * (1.f / KVLR) + EPS);
                unsigned char* d = ws + WS_VF + ((size_t)(head * (NTOK / 64) + (tb >> 6)) * 4) * 1024 + (i & 1) * 1024 + lane * 16;
#pragma unroll
                for (int j = 0; j < 2; ++j) {
                    float v[16];
#pragma unroll
                    for (int r = 0; r < 16; ++r) v[r] = acc[i][j][r] * rs[r];
                    *(u32x4*)(d + j * 2048) = pack16_fp8(v);
                }
            }
        }
    }
};
struct EpiOut {
    unsigned char* ws;
    template <int MI> __device__ __forceinline__ void operator()(f32x16 (&acc)[MI][2], int mt, int nt, int wm, int wn, int r32, int hi) const {
        float* ssq = (float*)(ws + WS_SSQ) + 2 * NTOK;
        bf16_t* ob = (bf16_t*)(ws + WS_XN);
#pragma unroll
        for (int i = 0; i < MI; ++i) {
            const int tok = mt * (64 * MI) + wm * (32 * MI) + 32 * i + r32; float ss = 0.f;
            bf16_t* d = ob + (size_t)tok * DM + nt * 128 + wn * 64 + 8 * hi;
#pragma unroll
            for (int j = 0; j < 2; ++j)
#pragma unroll
                for (int q = 0; q < 2; ++q) {
                    float v[8];
#pragma unroll
                    for (int e = 0; e < 8; ++e) { v[e] = acc[i][j][8 * q + e]; ss += v[e] * v[e]; }
                    *(u32x4*)(d + 32 * j + 16 * q) = pack8(v);
                }
            ss = swap32_sum(ss);
            if (hi == 0) atomicAdd(ssq + tok, ss);
        }
    }
};

__device__ __forceinline__ void conv_phase(const Params& p, int gtid, int gthreads) {
    const bf16_t* cu = (const bf16_t*)(p.ws + WS_CU); const bf16_t* gz = (const bf16_t*)(p.ws + WS_GZ); bf16_t* mixa = (bf16_t*)(p.ws + WS_MIXA);
    for (int id = gtid; id < NTOK * 64; id += gthreads) {
        const int tok = id >> 6, c0 = (id & 63) * 8, pos = tok_pos(tok), S = tok < NTOK_P ? SEQ_P : SEQ_S;
        const u32x4 z4 = {0u, 0u, 0u, 0u};
        const u32x4 cm = *(const u32x4*)(cu + (size_t)tok * CW + c0);
        const u32x4 cl = pos > 0 ? *(const u32x4*)(cu + (size_t)(tok - 1) * CW + c0) : z4;
        const u32x4 cr = pos < S - 1 ? *(const u32x4*)(cu + (size_t)(tok + 1) * CW + c0) : z4;
        const u32x4 g = *(const u32x4*)(gz + (size_t)tok * CW + c0);
        float w0[8], w1[8], w2[8], o[8];
#pragma unroll
        for (int e = 0; e < 8; ++e) { w0[e] = p.conv_w[c0 + e]; w1[e] = p.conv_w[CW + c0 + e]; w2[e] = p.conv_w[2 * CW + c0 + e]; }
#pragma unroll
        for (int e = 0; e < 4; ++e) {
            o[2 * e] = bf_lo(g[e]) * (w0[2 * e] * bf_lo(cl[e]) + w1[2 * e] * bf_lo(cm[e]) + w2[2 * e] * bf_lo(cr[e]));
            o[2 * e + 1] = bf_hi(g[e]) * (w0[2 * e + 1] * bf_hi(cl[e]) + w1[2 * e + 1] * bf_hi(cm[e]) + w2[2 * e + 1] * bf_hi(cr[e]));
        }
        *(u32x4*)(mixa + (size_t)tok * CW + c0) = pack8(o);
    }
}

constexpr int AT_STAGE = 40960, AT_NSLOT = 3;
static_assert(AT_NSLOT * AT_STAGE <= LDS_BYTES, "attention ring");
__device__ __forceinline__ float max3f(float a, float b, float c) { float r; asm("v_max3_f32 %0, %1, %2, %3" : "=v"(r) : "v"(a), "v"(b), "v"(c)); return r; }
__device__ __forceinline__ float max2f_pad(float a, float b) { float r; asm("v_max_f32_e32 %0, %1, %2\n\ts_nop 1" : "=v"(r) : "v"(a), "v"(b)); return r; }
#define AT_PIN(x) asm volatile("" : "+v"(x))
__device__ __forceinline__ void attn_dma(unsigned lds0, int slot, const unsigned char* kt, const unsigned char* vt, int wid, int lane) {
#pragma unroll
    for (int it = 0; it < 5; ++it) {
        const int pc = wid + 8 * it;
        const unsigned char* src = (it < 3) ? kt + pc * 1024 + lane * 16 : vt + (pc - 24) * 1024 + lane * 16;
        glds16(src, (unsigned)__builtin_amdgcn_readfirstlane((int)(lds0 + slot * AT_STAGE + pc * 1024)));
    }
}
__device__ __forceinline__ void attn_unit(unsigned char* lds, const Params& p, int head, int tok0, int S, int qblk) {
    const int tid = threadIdx.x, lane = tid & 63, wid = __builtin_amdgcn_readfirstlane(tid >> 6), r32 = lane & 31, hi = lane >> 5;
    const unsigned lds0 = (unsigned)(uintptr_t)lds;
    const int tq0 = tok0 + qblk * 256 + wid * 32;
    const unsigned char* kbase = p.ws + WS_KF + (size_t)(head * NBLK32 + (tok0 >> 5)) * 3072;
    const unsigned char* vbase = p.ws + WS_VF + (size_t)(head * (NTOK / 64) + (tok0 >> 6)) * 4096;
    const int NU = S / 256;
    attn_dma(lds0, 0, kbase, vbase, wid, lane);
    attn_dma(lds0, 1, kbase + 24576, vbase + 16384, wid, lane);
    u32x4 q0, q1, q2;
    { const unsigned char* qp = p.ws + WS_QF + (size_t)(head * NBLK32 + (tq0 >> 5)) * 3072 + lane * 16;
      q0 = *(const u32x4*)qp; q1 = *(const u32x4*)(qp + 1024); q2 = *(const u32x4*)(qp + 2048); }
    const u32x4 zz = {0u, 0u, 0u, 0u};
    f32x16 o0, o1, negm;
#pragma unroll
    for (int r = 0; r < 16; ++r) { o0[r] = 0.f; o1[r] = 0.f; negm[r] = 0.f; }
    AT_PIN(negm);
    float mref = 0.f;
    f32x16 lacc;
#pragma unroll
    for (int r = 0; r < 16; ++r) lacc[r] = 0.f;
    const u32x4 ones8 = {0x38383838u, 0x38383838u, 0x38383838u, 0x38383838u};
    AT_WAIT_BAR(5);
    int slot = 0;
    for (int u = 0; u < NU; ++u) {
        const bool pf = u + 2 < NU;
        const int s2 = slot == 0 ? 2 : slot - 1;
#pragma unroll
        for (int h = 0; h < 4; ++h) {
            if (pf && (wid & 3) == h) attn_dma(lds0, s2, kbase + (size_t)(u + 2) * 24576, vbase + (size_t)(u + 2) * 16384, wid, lane);
            const unsigned char* kb = lds + slot * AT_STAGE + h * 6144 + lane * 16;
            const unsigned char* vb = lds + slot * AT_STAGE + 24576 + h * 4096 + lane * 16;
            f32x16 s0, s1;
            { const u32x4 a0 = *(const u32x4*)(kb), a1 = *(const u32x4*)(kb + 1024), a2 = *(const u32x4*)(kb + 2048);
              const u32x4 b0 = *(const u32x4*)(kb + 3072), b1 = *(const u32x4*)(kb + 4096), b2 = *(const u32x4*)(kb + 5120);
              s0 = mfma8(a0, a1, q0, q1, negm); s1 = mfma8(b0, b1, q0, q1, negm);
              s0 = mfma8(a2, zz, q2, zz, s0);   s1 = mfma8(b2, zz, q2, zz, s1); }
            asm volatile("s_nop 15\n\ts_nop 15" : "+v"(s0), "+v"(s1));
            float ma = max3f(s0[0], s0[1], s1[0]), mb = max3f(s0[2], s0[3], s1[1]); ma = max3f(ma, s1[2], s1[3]);
#pragma unroll
            for (int r = 4; r < 16; r += 4) { ma = max3f(ma, s0[r], s0[r + 1]); mb = max3f(mb, s0[r + 2], s0[r + 3]); ma = max3f(ma, s1[r], s1[r + 1]); mb = max3f(mb, s1[r + 2], s1[r + 3]); }
            float mx = max2f_pad(ma, mb);
            { auto rr = __builtin_amdgcn_permlane32_swap(__float_as_uint(mx), __float_as_uint(mx), false, false); mx = fmaxf(__uint_as_float(rr[0]), __uint_as_float(rr[1])); }
            const bool first = (u == 0) && (h == 0);
            if (__builtin_expect(first || __any(mx > 7.5f), 0)) {
                const float d = first ? mx - 6.f : fmaxf(mx - 6.f, 0.f);
                mref += d;
                const float f = __builtin_amdgcn_exp2f(-d);
#pragma unroll
                for (int r = 0; r < 16; ++r) { s0[r] -= d; s1[r] -= d; o0[r] *= f; o1[r] *= f; lacc[r] *= f; negm[r] = -mref; }
                AT_PIN(negm);
            }
#pragma unroll
            for (int r = 0; r < 16; ++r) { s0[r] = __builtin_amdgcn_exp2f(s0[r]); s1[r] = __builtin_amdgcn_exp2f(s1[r]); }
            float pv0[16], pv1[16];
#pragma unroll
            for (int r = 0; r < 16; ++r) { pv0[r] = s0[r]; pv1[r] = s1[r]; }
            const u32x4 p0 = pack16_fp8(pv0), p1 = pack16_fp8(pv1);
            { const u32x4 v00 = *(const u32x4*)(vb), v01 = *(const u32x4*)(vb + 1024), v10 = *(const u32x4*)(vb + 2048), v11 = *(const u32x4*)(vb + 3072);
              o0 = mfma8(v00, v01, p0, p1, o0); o1 = mfma8(v10, v11, p0, p1, o1); lacc = mfma8(ones8, ones8, p0, p1, lacc); }
        }
        if (pf) AT_WAIT_BAR(5); else AT_WAIT_BAR(0);
        slot = slot == 2 ? 0 : slot + 1;
    }
    const float inv = 1.f / lacc[0];
    const int tok = tq0 + r32;
    const bf16_t* sz = (const bf16_t*)(p.ws + WS_SZ) + (size_t)tok * AW + head * 64 + 8 * hi;
    bf16_t* mo = (bf16_t*)(p.ws + WS_MIX2) + (size_t)tok * AW + head * 64 + 8 * hi;
#pragma unroll
    for (int d0 = 0; d0 < 2; ++d0)
#pragma unroll
        for (int q8 = 0; q8 < 2; ++q8) {
            const u32x4 g = *(const u32x4*)(sz + 32 * d0 + 16 * q8);
            float v[8];
#pragma unroll
            for (int e = 0; e < 4; ++e) {
                const float a = d0 == 0 ? o0[8 * q8 + 2 * e] : o1[8 * q8 + 2 * e], b = d0 == 0 ? o0[8 * q8 + 2 * e + 1] : o1[8 * q8 + 2 * e + 1];
                v[2 * e] = a * inv * bf_lo(g[e]); v[2 * e + 1] = b * inv * bf_hi(g[e]);
            }
            *(u32x4*)(mo + 32 * d0 + 16 * q8) = pack8(v);
        }
}


constexpr size_t WS_BAR = 640 * 1024;
#define XB_TMO      128
#define XB_XCNT(j)  (256  + 64 * (j))
#define XB_XSUB(j)  (1280 + 64 * (j))
#define XB_XGEN(j)  (2304 + 64 * (j))
#define XB_TOP      3328
#define XB_TOPGEN   3392
#define XCD_BAR_WORDS 3456
#define XB_SPIN_CAP (1u << 18)
__device__ __forceinline__ unsigned xb_ld(unsigned* p)              { return __hip_atomic_load(p, __ATOMIC_RELAXED, __HIP_MEMORY_SCOPE_AGENT); }
__device__ __forceinline__ unsigned xb_add(unsigned* p, unsigned v) { return __hip_atomic_fetch_add(p, v, __ATOMIC_RELAXED, __HIP_MEMORY_SCOPE_AGENT); }
__device__ __forceinline__ unsigned xb_xcc_id() { return (unsigned)__builtin_amdgcn_s_getreg((3 << 11) | 20) & 0xFu; }
#define XB_SPIN(cond, bar) do { unsigned _sp = 0; while (cond) { __builtin_amdgcn_s_sleep(1); \
    if ((++_sp & 255u) == 0u) { if (xb_ld(&(bar)[XB_TMO])) break; if (_sp > XB_SPIN_CAP) { atomicAdd(&(bar)[XB_TMO], 1u); break; } } } } while (0)
struct XcdBarrier { unsigned* bar; unsigned x; unsigned nloc, nx; };
__device__ __forceinline__ XcdBarrier xcd_barrier_post(unsigned* bar) {
    XcdBarrier b; b.bar = bar; b.x = xb_xcc_id(); b.nloc = 0u; b.nx = 0u;
    if (threadIdx.x == 0) (void)xb_add(&bar[XB_XCNT(b.x)], 1u);
    return b;
}
__device__ __forceinline__ void xcd_barrier_complete(unsigned* bar, unsigned x, unsigned& nloc, unsigned& nx) {
    const unsigned G = gridDim.x * gridDim.y * gridDim.z;
    unsigned sum, cnt, mine, sp = 0u;
    for (;;) {
        sum = 0u; cnt = 0u; mine = 0u;
#pragma unroll
        for (unsigned j = 0; j < 16; ++j) { const unsigned c = xb_ld(&bar[XB_XCNT(j)]); sum += c; cnt += (c > 0u) ? 1u : 0u; mine = (j == x) ? c : mine; }
        if (sum == G) break;
        __builtin_amdgcn_s_sleep(1);
        if ((++sp & 255u) == 0u) { if (xb_ld(&bar[XB_TMO])) break; if (sp > XB_SPIN_CAP) { atomicAdd(&bar[XB_TMO], 1u); break; } }
    }
    nloc = mine > 0u ? mine : 1u; nx = cnt > 0u ? cnt : 1u;
}
__device__ __forceinline__ void xcd_barrier(XcdBarrier& b) {
    asm volatile("s_waitcnt vmcnt(0)" ::: "memory");
    __syncthreads();
    if (threadIdx.x == 0) {
        unsigned* bar = b.bar;
        __builtin_amdgcn_s_waitcnt(0);
        unsigned nloc = b.nloc, nx = b.nx;
        if (nloc == 0u) { xcd_barrier_complete(bar, b.x, nloc, nx); b.nloc = nloc; b.nx = nx; }
        const unsigned old = xb_add(&bar[XB_XSUB(b.x)], 1u);
        const unsigned gen = old / nloc;
        if (old + 1u == (gen + 1u) * nloc) {
            __builtin_amdgcn_fence(__ATOMIC_RELEASE, "agent");
            asm volatile("s_waitcnt vmcnt(0)" ::: "memory");
            const unsigned og = xb_add(&bar[XB_TOP], 1u);
            const unsigned tg = og / nx;
            if (og + 1u == (tg + 1u) * nx) xb_add(&bar[XB_TOPGEN], 1u);
            else XB_SPIN(xb_ld(&bar[XB_TOPGEN]) == tg, bar);
            __builtin_amdgcn_fence(__ATOMIC_ACQUIRE, "agent");
            xb_add(&bar[XB_XGEN(b.x)], 1u);
            asm volatile("s_waitcnt vmcnt(0)" ::: "memory");
        } else {
            XB_SPIN(xb_ld(&bar[XB_XGEN(b.x)]) == gen, bar);
            __builtin_amdgcn_fence(__ATOMIC_ACQUIRE, "agent");
            asm volatile("s_waitcnt vmcnt(0)" ::: "memory");
        }
    }
    __syncthreads();
}

__global__ void __launch_bounds__(NTHR, 2) fwd_kernel(Params p) {
    extern __shared__ __attribute__((aligned(16))) unsigned char lds[];
    cg::grid_group grid = cg::this_grid();
    const int G = gridDim.x, bx = blockIdx.x, tid = threadIdx.x;
    const int gtid = bx * NTHR + tid, gthreads = G * NTHR;
    const int xcd = bx & 7, lb = bx >> 3, GX = G >> 3;
    unsigned char* ws = p.ws;

    __syncthreads();
    XcdBarrier xbar = xcd_barrier_post((unsigned*)(ws + WS_BAR));
    if (p.ws == nullptr) grid.sync();
    phase0(p, gtid, gthreads);
    xcd_barrier(xbar);

    { EpiIn E{ws}; const bf16_t* xn = (const bf16_t*)(ws + WS_XN); const bf16_t* W = (const bf16_t*)(ws + WS_WIN);
      gemm_dma<4, 2, 0>(lds, xn, xn, 1 << 30, DM, W, DM, 13, xcd, lb, GX, E); }
    xcd_barrier(xbar);

    { EpiQ E{ws}; const bf16_t* A = (const bf16_t*)(ws + WS_QLAT); const bf16_t* W = (const bf16_t*)(ws + WS_WUQ);
      gemm_dma<2, 3, 0>(lds, A, A, 1 << 30, QLR, W, QLR, 2, xcd, lb, GX, E); }
    { EpiKV E{ws}; const bf16_t* A = (const bf16_t*)(ws + WS_KVLAT); const bf16_t* W = (const bf16_t*)(ws + WS_WUKV);
      gemm_dma<4, 2, 1>(lds, A, A, 1 << 30, KVLR, W, KVLR, 4, xcd, lb, GX, E); }
    conv_phase(p, gtid, gthreads);
    xcd_barrier(xbar);

    for (int w = lb; w < 128; w += GX) { const int bl = w >> 6, qblk = w & 63; attn_unit(lds, p, xcd, NTOK_P + bl * SEQ_S, SEQ_S, qblk); }
    { unsigned* tick = (unsigned*)(ws + WS_BAR) + 3584 + 64 * xcd;
      for (;;) {
          if (tid == 0) *(volatile unsigned*)lds = xb_add(tick, 1u);
          __syncthreads();
          const unsigned w2 = *(volatile unsigned*)lds;
          __syncthreads();
          if (w2 >= 64u) break;
          attn_unit(lds, p, (int)(w2 >> 3), xcd * SEQ_P, SEQ_P, (int)(w2 & 7));
      } }
    xcd_barrier(xbar);

    { EpiOut E{ws}; const bf16_t* A0 = (const bf16_t*)(ws + WS_MIXA); const bf16_t* A1 = (const bf16_t*)(ws + WS_MIX2); const bf16_t* W = (const bf16_t*)(ws + WS_WOUT);
      gemm_dma<4, 2, 0>(lds, A0, A1, 512, CW, W, DM, 4, xcd, lb, GX, E); }
    xcd_barrier(xbar);

    { const float* ssq = (const float*)(ws + WS_SSQ) + 2 * NTOK; const bf16_t* ob = (const bf16_t*)(ws + WS_XN);
      const int lane = tid & 63, gw = gtid >> 6, nw = gthreads >> 6;
      f32x4 g[4];
#pragma unroll
      for (int j = 0; j < 4; ++j) g[j] = *(const f32x4*)(p.norm_post + 4 * lane + 256 * j);
      for (int row = gw * 2; row < NTOK; row += nw * 2) {
          f32x4 xv[2][4]; u32x2 ov[2][4]; float rs[2];
#pragma unroll
          for (int u = 0; u < 2; ++u) {
              const float* xr = xrow(p, row + u) + 4 * lane; const bf16_t* orow = ob + (size_t)(row + u) * DM + 4 * lane;
#pragma unroll
              for (int j = 0; j < 4; ++j) { xv[u][j] = *(const f32x4*)(xr + 256 * j); ov[u][j] = *(const u32x2*)(orow + 256 * j); }
              rs[u] = rsqrtf(ssq[row + u] * (1.f / DM) + EPS);
          }
#pragma unroll
          for (int u = 0; u < 2; ++u) {
              float* yr = p.out + (size_t)(row + u) * DM + 4 * lane;
#pragma unroll
              for (int j = 0; j < 4; ++j) {
                  f32x4 o; o.x = bf_lo(ov[u][j].x); o.y = bf_hi(ov[u][j].x); o.z = bf_lo(ov[u][j].y); o.w = bf_hi(ov[u][j].y);
                  *(f32x4*)(yr + 256 * j) = xv[u][j] + o * rs[u] * g[j];
              }
          }
      } }
}

extern "C" void kernel_launch(void* const* d_in, const int* in_sizes, int n_in, void* d_out, int out_size, void* d_ws, size_t ws_size, hipStream_t stream) {
    static int grid_blocks = 0;
    if (!grid_blocks) {
        int dev = 0, cus = 0, per_cu = 0;
        hipGetDevice(&dev);
        hipDeviceGetAttribute(&cus, hipDeviceAttributeMultiprocessorCount, dev);
        hipFuncSetAttribute((const void*)fwd_kernel, hipFuncAttributeMaxDynamicSharedMemorySize, LDS_BYTES);
        hipOccupancyMaxActiveBlocksPerMultiprocessor(&per_cu, (const void*)fwd_kernel, NTHR, LDS_BYTES);
        if (per_cu < 1) per_cu = 1;
        if (per_cu > 1) per_cu = 1;
        grid_blocks = cus * per_cu;
        if (ws_size < WS_END) fprintf(stderr, "kernel_launch: workspace too small (%zu < %zu)\n", ws_size, (size_t)WS_END);
    }
    (void)hipMemsetAsync((unsigned char*)d_ws + WS_BAR, 0, 16384, stream);
    Params p{};
    p.x_prompt = (const float*)d_in[0]; p.x_sample = (const float*)d_in[1]; p.norm_pre = (const float*)d_in[2]; p.w_in = (const float*)d_in[3];
    p.conv_w = (const float*)d_in[4]; p.q_norm = (const float*)d_in[5]; p.w_uq = (const float*)d_in[6]; p.kv_norm = (const float*)d_in[7];
    p.w_ukv = (const float*)d_in[8]; p.w_out = (const float*)d_in[9]; p.norm_post = (const float*)d_in[10];
    p.out = (float*)d_out; p.ws = (unsigned char*)d_ws;
    void* args[] = {&p};
    hipError_t e = hipLaunchCooperativeKernel((const void*)fwd_kernel, dim3(grid_blocks), dim3(NTHR), args, LDS_BYTES, stream);
    if (e != hipSuccess) fprintf(stderr, "cooperative launch failed: %s (grid %d)\n", hipGetErrorString(e), grid_blocks);
}
```

```cpp
#include <hip/hip_runtime.h>
#include <hip/hip_cooperative_groups.h>
#include <cstdio>
#include <cstdint>
namespace cg = cooperative_groups;

typedef unsigned short bf16_t;
typedef short bf16x8 __attribute__((ext_vector_type(8)));
typedef float f32x16 __attribute__((ext_vector_type(16)));
typedef float f32x4 __attribute__((ext_vector_type(4)));
typedef float f32x2 __attribute__((ext_vector_type(2)));
typedef unsigned u32x4 __attribute__((ext_vector_type(4)));
typedef unsigned u32x2 __attribute__((ext_vector_type(2)));
#define LAS __attribute__((address_space(3)))

constexpr int DM = 1024, NTOK = 49152, NTOK_P = 16384, SEQ_P = 2048, SEQ_S = 16384;
constexpr int CW = 512, NH = 8, QLR = 384, KVLR = 256, ROPE = 32, AW = 512;
constexpr int NIN = 3328;
constexpr int NBLK32 = NTOK / 32;
constexpr float EPS = 1e-6f;
constexpr float C2 = 0.14724444f;

constexpr size_t MiB = 1u << 20;
constexpr size_t WS_SSQ = 0;
constexpr size_t WS_COS = 1 * MiB, WS_SIN = 2 * MiB;
constexpr size_t WS_WIN = 3 * MiB;
constexpr size_t WS_WUQ = 10 * MiB;
constexpr size_t WS_WUKV = 11 * MiB;
constexpr size_t WS_WOUT = 12 * MiB;
constexpr size_t WS_XN = 16 * MiB;
constexpr size_t WS_QF = 16 * MiB;
constexpr size_t WS_CU = 112 * MiB;
constexpr size_t WS_GZ = 160 * MiB;
constexpr size_t WS_SZ = 208 * MiB;
constexpr size_t WS_QLAT = 256 * MiB;
constexpr size_t WS_KVLAT = 292 * MiB;
constexpr size_t WS_MIX2 = 256 * MiB;
constexpr size_t WS_KF = 316 * MiB;
constexpr size_t WS_VF = 388 * MiB;
constexpr size_t WS_MIXA = 436 * MiB;
constexpr size_t WS_END = 484 * MiB;

constexpr int LDS_BYTES = 131072;
constexpr int NTHR = 512;

struct Params {
    const float* x_prompt; const float* x_sample; const float* norm_pre; const float* w_in; const float* conv_w;
    const float* q_norm; const float* w_uq; const float* kv_norm; const float* w_ukv; const float* w_out; const float* norm_post;
    float* out; unsigned char* ws;
};

__device__ __forceinline__ unsigned pk_bf16(float lo, float hi) {
    typedef __bf16 b2 __attribute__((ext_vector_type(2)));
    f32x2 v = {lo, hi}; b2 b = __builtin_convertvector(v, b2); return __builtin_bit_cast(unsigned, b);
}
__device__ __forceinline__ float bf_lo(unsigned u) { return __uint_as_float(u << 16); }
__device__ __forceinline__ float bf_hi(unsigned u) { return __uint_as_float(u & 0xffff0000u); }
__device__ __forceinline__ u32x4 pack8(const float* v) {
    u32x4 w; w.x = pk_bf16(v[0], v[1]); w.y = pk_bf16(v[2], v[3]); w.z = pk_bf16(v[4], v[5]); w.w = pk_bf16(v[6], v[7]); return w;
}
typedef int i32x8 __attribute__((ext_vector_type(8)));
__device__ __forceinline__ u32x4 pack16_fp8(const float* v) {
    u32x4 w;
#pragma unroll
    for (int k = 0; k < 4; ++k) { int t = __builtin_amdgcn_cvt_pk_fp8_f32(v[4 * k], v[4 * k + 1], 0, false); t = __builtin_amdgcn_cvt_pk_fp8_f32(v[4 * k + 2], v[4 * k + 3], t, true); w[k] = (unsigned)t; }
    return w;
}
__device__ __forceinline__ f32x16 mfma8(u32x4 a0, u32x4 a1, u32x4 b0, u32x4 b1, f32x16 c) {
    const i32x8 A = {(int)a0.x, (int)a0.y, (int)a0.z, (int)a0.w, (int)a1.x, (int)a1.y, (int)a1.z, (int)a1.w};
    const i32x8 B = {(int)b0.x, (int)b0.y, (int)b0.z, (int)b0.w, (int)b1.x, (int)b1.y, (int)b1.z, (int)b1.w};
    return __builtin_amdgcn_mfma_scale_f32_32x32x64_f8f6f4(A, B, c, 0, 0, 0, 0x7f7f7f7f, 0, 0x7f7f7f7f);
}
__device__ __forceinline__ float silu_f(float z) { return z / (1.f + __expf(-z)); }
__device__ __forceinline__ int cperm(int p) { const int hp = (p >> 2) & 1, r = (p & 3) + 4 * (p >> 3); return 16 * (r >> 3) + 8 * hp + (r & 7); }
__device__ __forceinline__ int crow(int r, int hi) { return (r & 3) + 8 * (r >> 2) + 4 * hi; }
__device__ __forceinline__ float swap32_max(float m) {
    auto rr = __builtin_amdgcn_permlane32_swap(__float_as_uint(m), __float_as_uint(m), false, false);
    return fmaxf(__uint_as_float(rr[0]), __uint_as_float(rr[1]));
}
__device__ __forceinline__ float swap32_sum(float m) {
    auto rr = __builtin_amdgcn_permlane32_swap(__float_as_uint(m), __float_as_uint(m), false, false);
    return __uint_as_float(rr[0]) + __uint_as_float(rr[1]);
}
__device__ __forceinline__ float wave_sum(float v) {
#pragma unroll
    for (int o = 1; o < 64; o <<= 1) v += __shfl_xor(v, o);
    return v;
}
__device__ __forceinline__ const float* xrow(const Params& p, int tok) {
    return tok < NTOK_P ? p.x_prompt + (size_t)tok * DM : p.x_sample + (size_t)(tok - NTOK_P) * DM;
}
__device__ __forceinline__ int tok_pos(int tok) { return tok < NTOK_P ? (tok & (SEQ_P - 1)) : (tok & (SEQ_S - 1)); }

__device__ __forceinline__ void glds16(const void* gsrc, unsigned lds_dst) {
    unsigned keep;
    asm volatile("s_mov_b32 %0, m0\n\ts_mov_b32 m0, %2\n\ts_nop 0\n\tglobal_load_lds_dwordx4 %1, off\n\ts_mov_b32 m0, %0" : "=&s"(keep) : "v"(gsrc), "s"(lds_dst) : "memory");
}
#define AT_WAIT_BAR(N) asm volatile("s_waitcnt vmcnt(" #N ") lgkmcnt(0)\n\ts_barrier" ::: "memory")
typedef __amdgpu_buffer_rsrc_t srd_t;
__device__ __forceinline__ srd_t make_srd(const void* base) { return __builtin_amdgcn_make_buffer_rsrc((void*)base, (short)0, 0x7ffffffe, 0x00020000); }
__device__ __forceinline__ void bdma16(unsigned m0v, unsigned voff, srd_t srd, unsigned soff) {
    asm volatile("s_nop 4\n\ts_mov_b32 m0, %0\n\ts_nop 0\n\tbuffer_load_dwordx4 %1, %2, %3 offen lds" :: "s"(m0v), "v"(voff), "s"(srd), "s"(soff) : "m0", "memory");
}
__device__ __forceinline__ unsigned rflu(unsigned v) { return (unsigned)__builtin_amdgcn_readfirstlane((int)v); }

__device__ __forceinline__ int win_src(int np) {
    const int T = np >> 7, w = np & 127;
    if (T < 16) { const int wn = w >> 6, j = (w >> 5) & 1, q = (w >> 4) & 1, i16 = w & 15; return (2 * j + q) * 512 + 32 * T + 16 * wn + i16; }
    if (T < 21) return np;
    if (T < 25) return 2720 + (np - 2688);
    return w < 32 ? 2688 + w : -1;
}
template <int MODE>
__device__ __forceinline__ void prep_weight(const float* __restrict__ w, const float* __restrict__ gain, bf16_t* WT, int K, int Nsrc, int Ndst, int gtid, int gthreads) {
    const int items = Ndst * (K / 8);
    for (int id = gtid; id < items; id += gthreads) {
        const int n = id % Ndst, kc = id / Ndst, k0 = kc * 8;
        const int src = (MODE == 1) ? win_src(n) : n;
        float v[8];
#pragma unroll
        for (int e = 0; e < 8; ++e) v[e] = (src >= 0) ? w[(size_t)(k0 + e) * Nsrc + src] * (gain ? gain[k0 + e] : 1.f) : 0.f;
        *(u32x4*)(WT + (size_t)n * K + k0) = pack8(v);
    }
}
__device__ __forceinline__ void rope_entry(int pos, int i, float& c, float& s) {
    const int a = i & 3, b = i >> 2;
    double base = a == 0 ? 1.0 : a == 1 ? 0.5623413251903491 : a == 2 ? 0.31622776601683794 : 0.1778279410038923;
    double sc = b == 0 ? 1.0 : b == 1 ? 0.1 : b == 2 ? 0.01 : 0.001;
    const float freq = (float)(base * sc);
    const float angf = (float)pos * freq;
    const double x = (double)angf;
    const double kq = rint(x * 0.6366197723675814);
    const double r = (x - kq * 1.5707963267948966) - kq * 6.123233995736766e-17;
    const double r2 = r * r;
    const double sn = r * (1.0 + r2 * (-1.0 / 6 + r2 * (1.0 / 120 + r2 * (-1.0 / 5040 + r2 * (1.0 / 362880 + r2 * (-1.0 / 39916800))))));
    const double cs = 1.0 + r2 * (-0.5 + r2 * (1.0 / 24 + r2 * (-1.0 / 720 + r2 * (1.0 / 40320 + r2 * (-1.0 / 3628800 + r2 * (1.0 / 479001600))))));
    const int qd = ((int)kq) & 3;
    const double so = qd == 0 ? sn : qd == 1 ? cs : qd == 2 ? -sn : -cs;
    const double co = qd == 0 ? cs : qd == 1 ? -sn : qd == 2 ? -cs : sn;
    c = (float)co; s = (float)so;
}
__device__ __forceinline__ void phase0(const Params& p, int gtid, int gthreads) {
    unsigned char* ws = p.ws;
    float* ssq = (float*)(ws + WS_SSQ);
    for (int i = gtid; i < 3 * NTOK; i += gthreads) ssq[i] = 0.f;
    float* ct = (float*)(ws + WS_COS); float* st = (float*)(ws + WS_SIN);
    for (int i = gtid; i < SEQ_S * 16; i += gthreads) { float c, s; rope_entry(i >> 4, i & 15, c, s); ct[i] = c; st[i] = s; }
    prep_weight<1>(p.w_in, p.norm_pre, (bf16_t*)(ws + WS_WIN), DM, 3232, NIN, gtid, gthreads);
    prep_weight<0>(p.w_uq, p.q_norm, (bf16_t*)(ws + WS_WUQ), QLR, 768, 768, gtid, gthreads);
    prep_weight<0>(p.w_ukv, p.kv_norm, (bf16_t*)(ws + WS_WUKV), KVLR, 1024, 1024, gtid, gthreads);
    prep_weight<0>(p.w_out, nullptr, (bf16_t*)(ws + WS_WOUT), DM, 1024, 1024, gtid, gthreads);
    const int gw = gtid >> 6, nw = gthreads >> 6, lane = threadIdx.x & 63;
    bf16_t* xn = (bf16_t*)(ws + WS_XN);
    for (int row = gw * 2; row < NTOK; row += nw * 2) {
        f32x4 v[2][4]; float s[2];
#pragma unroll
        for (int u = 0; u < 2; ++u) {
            const f32x4* xr = (const f32x4*)xrow(p, row + u) + lane; s[u] = 0.f;
#pragma unroll
            for (int j = 0; j < 4; ++j) { v[u][j] = xr[64 * j]; }
        }
#pragma unroll
        for (int u = 0; u < 2; ++u) {
#pragma unroll
            for (int j = 0; j < 4; ++j) s[u] += (v[u][j].x * v[u][j].x + v[u][j].y * v[u][j].y) + (v[u][j].z * v[u][j].z + v[u][j].w * v[u][j].w);
            const float rs = rsqrtf(wave_sum(s[u]) * (1.f / DM) + EPS);
            u32x2* o = (u32x2*)(xn + (size_t)(row + u) * DM) + lane;
#pragma unroll
            for (int j = 0; j < 4; ++j) { u32x2 w; w.x = pk_bf16(v[u][j].x * rs, v[u][j].y * rs); w.y = pk_bf16(v[u][j].z * rs, v[u][j].w * rs); o[64 * j] = w; }
        }
    }
}

__device__ __forceinline__ void tile_map(int w, int NT, int xcd, int MPX, int& mt, int& nt) {
    const int g = w / (8 * NT), rem = w % (8 * NT);
    nt = rem >> 3; mt = xcd * MPX + g * 8 + (rem & 7);
}
template <int MI, int NJ, int MODE, class Epi>
__device__ __forceinline__ void gemm_dma(unsigned char* lds, const bf16_t* __restrict__ A0, const bf16_t* __restrict__ A1, int ksplit, int lda,
                                         const bf16_t* __restrict__ Bt, int K, int NT, int xcd, int lb, int GX, const Epi& epi) {
    constexpr int NSA = 4 * MI, NSUB = 4 * MI + 8 * NJ, STAGE = NSUB * 1024, NIT = NSUB / 8, NITA = NSA / 8, BOFF = NSA * 1024, MPX = 96 / MI;
    static_assert(4 * STAGE <= LDS_BYTES && NSUB % 8 == 0 && NSA % 8 == 0, "lds");
    const int tid = threadIdx.x, lane = tid & 63, wid = __builtin_amdgcn_readfirstlane(tid >> 6), wm = wid >> 2, wn = wid & 3;
    const int r32 = lane & 31, hi = lane >> 5;
    const unsigned lds0 = rflu((unsigned)(uintptr_t)lds);
    const int nk = K / 32, count = MPX * NT;
    int w = lb;
    if (w >= count) return;
    int mt, nt; tile_map(w, NT, xcd, MPX, mt, nt);
    const int rowl = lane >> 2, colsw = 8 * ((lane & 3) ^ ((lane >> 4) & 3));
    const unsigned voffA = (unsigned)((rowl * lda + colsw) * 2), voffB = (unsigned)((rowl * K + colsw) * 2);
    const srd_t srdA0 = make_srd(A0), srdA1 = make_srd(A1), srdB = make_srd(Bt);
    auto dma = [&](int tmt, int tnt, int kt, int stage) {
        const int k0 = kt * 32;
        const bool lo = k0 < ksplit;
        const unsigned sa = (unsigned)(tmt * 64 * MI) * (unsigned)(lda * 2) + (unsigned)((lo ? k0 : k0 - ksplit) * 2);
        const unsigned sbb = (unsigned)(tnt * 128 * NJ) * (unsigned)(K * 2) + (unsigned)(k0 * 2);
#pragma unroll
        for (int it = 0; it < NIT; ++it) {
            const int f = wid + 8 * it;
            const unsigned m0v = rflu(lds0 + (unsigned)(stage * STAGE + f * 1024));
            if (it < NITA) { const unsigned so = rflu(sa + (unsigned)(f * 16) * (unsigned)(lda * 2)); if (lo) bdma16(m0v, voffA, srdA0, so); else bdma16(m0v, voffA, srdA1, so); }
            else { const unsigned so = rflu(sbb + (unsigned)((f - NSA) * 16) * (unsigned)(K * 2)); bdma16(m0v, voffB, srdB, so); }
        }
    };
    const int cb = cperm(r32);
    const int arow = (wm * 32 * MI + r32), brow = (wn * 32 * NJ + cb);
    const int abase = (arow >> 4) * 1024 + (arow & 15) * 64, ax = (arow >> 2) & 3;
    const int bbase = BOFF + (brow >> 4) * 1024 + (brow & 15) * 64, bx_ = (brow >> 2) & 3;
    const bool swp = (MODE == 0) || ((wn & 1) == 0);
    f32x16 acc[MI][NJ];
    auto compute = [&](int stage) {
        const unsigned char* base = lds + stage * STAGE;
#pragma unroll
        for (int kk = 0; kk < 2; ++kk) {
            bf16x8 af[MI], bfr[NJ];
            const int ca = ((2 * kk + hi) ^ ax) << 4, cbb = ((2 * kk + hi) ^ bx_) << 4;
#pragma unroll
            for (int i = 0; i < MI; ++i) af[i] = *(const bf16x8*)(base + abase + i * 2048 + ca);
#pragma unroll
            for (int j = 0; j < NJ; ++j) bfr[j] = *(const bf16x8*)(base + bbase + j * 2048 + cbb);
#pragma unroll
            for (int i = 0; i < MI; ++i)
#pragma unroll
                for (int j = 0; j < NJ; ++j) {
                    if (MODE == 0) acc[i][j] = __builtin_amdgcn_mfma_f32_32x32x16_bf16(bfr[j], af[i], acc[i][j], 0, 0, 0);
                    else { const bf16x8 xa = swp ? bfr[j] : af[i], xb = swp ? af[i] : bfr[j]; acc[i][j] = __builtin_amdgcn_mfma_f32_32x32x16_bf16(xa, xb, acc[i][j], 0, 0, 0); }
                }
        }
    };
    auto dma2 = [&](int tmt, int tnt, int kt2, int sb) { dma(tmt, tnt, 2 * kt2, 2 * sb); dma(tmt, tnt, 2 * kt2 + 1, 2 * sb + 1); };
    dma2(mt, nt, 0, 0);
    int sb = 0;
    const int nk2 = nk >> 1;
    for (;;) {
        const int wnx = w + GX; const bool has_next = wnx < count;
        int mt2 = mt, nt2 = nt; if (has_next) tile_map(wnx, NT, xcd, MPX, mt2, nt2);
#pragma unroll
        for (int i = 0; i < MI; ++i)
#pragma unroll
            for (int j = 0; j < NJ; ++j)
#pragma unroll
                for (int r = 0; r < 16; ++r) acc[i][j][r] = 0.f;
        AT_WAIT_BAR(0);
        for (int kt2 = 0; kt2 < nk2; ++kt2) {
            const bool last = kt2 + 1 == nk2;
            if (wm == 0) { if (!last) dma2(mt, nt, kt2 + 1, sb ^ 1); else if (has_next) dma2(mt2, nt2, 0, sb ^ 1); }
            compute(2 * sb);
            if (wm != 0) { if (!last) dma2(mt, nt, kt2 + 1, sb ^ 1); else if (has_next) dma2(mt2, nt2, 0, sb ^ 1); }
            compute(2 * sb + 1);
            if (!last) AT_WAIT_BAR(0);
            sb ^= 1;
        }
        epi(acc, mt, nt * 2 + (wn >> 1), wm, wn & 1, r32, hi);
        if (!has_next) break;
        w = wnx; mt = mt2; nt = nt2;
    }
    AT_WAIT_BAR(0);
}

struct EpiIn {
    unsigned char* ws;
    template <int MI> __device__ __forceinline__ void operator()(f32x16 (&acc)[MI][2], int mt, int nt, int wm, int wn, int r32, int hi) const {
        const int lane = r32 + 32 * hi;
        if (nt < 16) {
            bf16_t* cu = (bf16_t*)(ws + WS_CU); bf16_t* gz = (bf16_t*)(ws + WS_GZ);
#pragma unroll
            for (int i = 0; i < MI; ++i) {
                const int tok = mt * (64 * MI) + wm * (32 * MI) + 32 * i + r32; const int ch0 = 32 * nt + 16 * wn + 8 * hi;
                float a[8], b[8];
#pragma unroll
                for (int e = 0; e < 8; ++e) { const float u = acc[i][0][e], B = acc[i][0][8 + e], C = acc[i][1][e], z = acc[i][1][8 + e]; a[e] = C * u; b[e] = B * silu_f(z); }
                *(u32x4*)(cu + (size_t)tok * CW + ch0) = pack8(a);
                *(u32x4*)(gz + (size_t)tok * CW + ch0) = pack8(b);
            }
        } else if (nt < 21) {
            const bool isq = nt < 19;
            bf16_t* dst = (bf16_t*)(ws + (isq ? WS_QLAT : WS_KVLAT)); const int ld = isq ? QLR : KVLR; const int cb = (isq ? (nt - 16) : (nt - 19)) * 128 + wn * 64 + 8 * hi;
            float* ssq = (float*)(ws + WS_SSQ) + (isq ? 0 : NTOK);
#pragma unroll
            for (int i = 0; i < MI; ++i) {
                const int tok = mt * (64 * MI) + wm * (32 * MI) + 32 * i + r32; float ss = 0.f;
#pragma unroll
                for (int j = 0; j < 2; ++j)
#pragma unroll
                    for (int q = 0; q < 2; ++q) {
                        float v[8];
#pragma unroll
                        for (int e = 0; e < 8; ++e) { v[e] = acc[i][j][8 * q + e]; ss += v[e] * v[e]; }
                        *(u32x4*)(dst + (size_t)tok * ld + cb + 32 * j + 16 * q) = pack8(v);
                    }
                ss = swap32_sum(ss);
                if (hi == 0) atomicAdd(ssq + tok, ss);
            }
        } else if (nt < 25) {
            bf16_t* sz = (bf16_t*)(ws + WS_SZ); const int cb = (nt - 21) * 128 + wn * 64 + 8 * hi;
#pragma unroll
            for (int i = 0; i < MI; ++i) {
                const int tok = mt * (64 * MI) + wm * (32 * MI) + 32 * i + r32;
#pragma unroll
                for (int j = 0; j < 2; ++j)
#pragma unroll
                    for (int q = 0; q < 2; ++q) {
                        float v[8];
#pragma unroll
                        for (int e = 0; e < 8; ++e) v[e] = silu_f(acc[i][j][8 * q + e]);
                        *(u32x4*)(sz + (size_t)tok * AW + cb + 32 * j + 16 * q) = pack8(v);
                    }
            }
        } else if (wn == 0) {
            const float* ct = (const float*)(ws + WS_COS); const float* st = (const float*)(ws + WS_SIN);
            unsigned char* kf = ws + WS_KF;
#pragma unroll
            for (int i = 0; i < MI; ++i) {
                const int tok = mt * (64 * MI) + wm * (32 * MI) + 32 * i + r32; const int pos = tok_pos(tok);
                const f32x4 c0 = *(const f32x4*)(ct + pos * 16 + 8 * hi), c1 = *(const f32x4*)(ct + pos * 16 + 8 * hi + 4);
                const f32x4 s0 = *(const f32x4*)(st + pos * 16 + 8 * hi), s1 = *(const f32x4*)(st + pos * 16 + 8 * hi + 4);
                float o[16];
#pragma unroll
                for (int e = 0; e < 8; ++e) { const float c = e < 4 ? c0[e & 3] : c1[e & 3], s = e < 4 ? s0[e & 3] : s1[e & 3]; const float x1 = acc[i][0][e], x2 = acc[i][0][8 + e]; o[e] = x1 * c - x2 * s; o[8 + e] = x2 * c + x1 * s; }
                const u32x4 w1 = pack16_fp8(o); const int blk = tok >> 5;
#pragma unroll
                for (int h = 0; h < NH; ++h) *(u32x4*)(kf + ((size_t)(h * NBLK32 + blk) * 3 + 2) * 1024 + lane * 16) = w1;
            }
        }
    }
};
struct EpiQ {
    unsigned char* ws;
    template <int MI> __device__ __forceinline__ void operator()(f32x16 (&acc)[MI][3], int mt, int nt, int wm, int wn, int r32, int hi) const {
        const int lane = r32 + 32 * hi, head = nt * 2 + wn;
        const float* ssq = (const float*)(ws + WS_SSQ);
        const float* ct = (const float*)(ws + WS_COS); const float* st = (const float*)(ws + WS_SIN);
#pragma unroll
        for (int i = 0; i < MI; ++i) {
            const int tok = mt * (64 * MI) + wm * (32 * MI) + 32 * i + r32; const int pos = tok_pos(tok);
            const float rs = rsqrtf(__hip_atomic_load(ssq + tok, __ATOMIC_RELAXED, __HIP_MEMORY_SCOPE_AGENT) * (1.f / QLR) + EPS) * C2;
            unsigned char* d = ws + WS_QF + ((size_t)(head * NBLK32 + (tok >> 5)) * 3) * 1024 + lane * 16;
#pragma unroll
            for (int j = 0; j < 2; ++j) {
                float v[16];
#pragma unroll
                for (int r = 0; r < 16; ++r) v[r] = acc[i][j][r] * rs;
                *(u32x4*)(d + j * 1024) = pack16_fp8(v);
            }
            const f32x4 c0 = *(const f32x4*)(ct + pos * 16 + 8 * hi), c1 = *(const f32x4*)(ct + pos * 16 + 8 * hi + 4);
            const f32x4 s0 = *(const f32x4*)(st + pos * 16 + 8 * hi), s1 = *(const f32x4*)(st + pos * 16 + 8 * hi + 4);
            float o[16];
#pragma unroll
            for (int e = 0; e < 8; ++e) { const float c = e < 4 ? c0[e & 3] : c1[e & 3], s = e < 4 ? s0[e & 3] : s1[e & 3]; const float x1 = acc[i][2][e] * rs, x2 = acc[i][2][8 + e] * rs; o[e] = x1 * c - x2 * s; o[8 + e] = x2 * c + x1 * s; }
            *(u32x4*)(d + 2 * 1024) = pack16_fp8(o);
        }
    }
};
struct EpiKV {
    unsigned char* ws;
    template <int MI> __device__ __forceinline__ void operator()(f32x16 (&acc)[MI][2], int mt, int nt, int wm, int wn, int r32, int hi) const {
        static_assert(MI % 2 == 0, "V fragments pair two 32-token blocks");
        const int lane = r32 + 32 * hi, head = nt;
        const float* ssq = (const float*)(ws + WS_SSQ) + NTOK;
        if (wn == 0) {
#pragma unroll
            for (int i = 0; i < MI; ++i) {
                const int tok = mt * (64 * MI) + wm * (32 * MI) + 32 * i + r32;
                const float rs = rsqrtf(__hip_atomic_load(ssq + tok, __ATOMIC_RELAXED, __HIP_MEMORY_SCOPE_AGENT) * (1.f / KVLR) + EPS);
                unsigned char* d = ws + WS_KF + ((size_t)(head * NBLK32 + (tok >> 5)) * 3) * 1024 + lane * 16;
#pragma unroll
                for (int j = 0; j < 2; ++j) {
                    float v[16];
#pragma unroll
                    for (int r = 0; r < 16; ++r) v[r] = acc[i][j][r] * rs;
                    *(u32x4*)(d + j * 1024) = pack16_fp8(v);
                }
            }
        } else {
#pragma unroll
            for (int i = 0; i < MI; ++i) {
                const int tb = mt * (64 * MI) + wm * (32 * MI) + 32 * i;
                float rs[16];
#pragma unroll
                for (int r = 0; r < 16; ++r) rs[r] = rsqrtf(__hip_atomic_load(ssq + tb + crow(r, hi), __ATOMIC_RELAXED, __HIP_MEMORY_SCOPE_AGENT) * (1.f / KVLR) + EPS);
                unsigned char* d = ws + WS_VF + ((size_t)(head * (NTOK / 64) + (tb >> 6)) * 4) * 1024 + (i & 1) * 1024 + lane * 16;
#pragma unroll
                for (int j = 0; j < 2; ++j) {
                    float v[16];
#pragma unroll
                    for (int r = 0; r < 16; ++r) v[r] = acc[i][j][r] * rs[r];
                    *(u32x4*)(d + j * 2048) = pack16_fp8(v);
                }
            }
        }
    }
};
struct EpiOut {
    unsigned char* ws;
    template <int MI> __device__ __forceinline__ void operator()(f32x16 (&acc)[MI][2], int mt, int nt, int wm, int wn, int r32, int hi) const {
        float* ssq = (float*)(ws + WS_SSQ) + 2 * NTOK;
        bf16_t* ob = (bf16_t*)(ws + WS_XN);
#pragma unroll
        for (int i = 0; i < MI; ++i) {
            const int tok = mt * (64 * MI) + wm * (32 * MI) + 32 * i + r32; float ss = 0.f;
            bf16_t* d = ob + (size_t)tok * DM + nt * 128 + wn * 64 + 8 * hi;
#pragma unroll
            for (int j = 0; j < 2; ++j)
#pragma unroll
                for (int q = 0; q < 2; ++q) {
                    float v[8];
#pragma unroll
                    for (int e = 0; e < 8; ++e) { v[e] = acc[i][j][8 * q + e]; ss += v[e] * v[e]; }
                    *(u32x4*)(d + 32 * j + 16 * q) = pack8(v);
                }
            ss = swap32_sum(ss);
            if (hi == 0) atomicAdd(ssq + tok, ss);
        }
    }
};

__device__ __forceinline__ void conv_phase(const Params& p, int gtid, int gthreads) {
    const bf16_t* cu = (const bf16_t*)(p.ws + WS_CU); const bf16_t* gz = (const bf16_t*)(p.ws + WS_GZ); bf16_t* mixa = (bf16_t*)(p.ws + WS_MIXA);
    for (int id = gtid; id < NTOK * 64; id += gthreads) {
        const int tok = id >> 6, c0 = (id & 63) * 8, pos = tok_pos(tok), S = tok < NTOK_P ? SEQ_P : SEQ_S;
        const u32x4 z4 = {0u, 0u, 0u, 0u};
        const u32x4 cm = *(const u32x4*)(cu + (size_t)tok * CW + c0);
        const u32x4 cl = pos > 0 ? *(const u32x4*)(cu + (size_t)(tok - 1) * CW + c0) : z4;
        const u32x4 cr = pos < S - 1 ? *(const u32x4*)(cu + (size_t)(tok + 1) * CW + c0) : z4;
        const u32x4 g = *(const u32x4*)(gz + (size_t)tok * CW + c0);
        float w0[8], w1[8], w2[8], o[8];
#pragma unroll
        for (int e = 0; e < 8; ++e) { w0[e] = p.conv_w[c0 + e]; w1[e] = p.conv_w[CW + c0 + e]; w2[e] = p.conv_w[2 * CW + c0 + e]; }
#pragma unroll
        for (int e = 0; e < 4; ++e) {
            o[2 * e] = bf_lo(g[e]) * (w0[2 * e] * bf_lo(cl[e]) + w1[2 * e] * bf_lo(cm[e]) + w2[2 * e] * bf_lo(cr[e]));
            o[2 * e + 1] = bf_hi(g[e]) * (w0[2 * e + 1] * bf_hi(cl[e]) + w1[2 * e + 1] * bf_hi(cm[e]) + w2[2 * e + 1] * bf_hi(cr[e]));
        }
        *(u32x4*)(mixa + (size_t)tok * CW + c0) = pack8(o);
    }
}

constexpr int AT_STAGE = 40960, AT_NSLOT = 3;
static_assert(AT_NSLOT * AT_STAGE <= LDS_BYTES, "attention ring");
__device__ __forceinline__ float max3f(float a, float b, float c) { float r; asm("v_max3_f32 %0, %1, %2, %3" : "=v"(r) : "v"(a), "v"(b), "v"(c)); return r; }
__device__ __forceinline__ float max2f_pad(float a, float b) { float r; asm("v_max_f32_e32 %0, %1, %2\n\ts_nop 1" : "=v"(r) : "v"(a), "v"(b)); return r; }
#define AT_PIN(x) asm volatile("" : "+v"(x))
__device__ __forceinline__ void attn_dma(unsigned lds0, int slot, srd_t srdK, srd_t srdV, unsigned koff, unsigned voffs, int wid, int lane) {
#pragma unroll
    for (int it = 0; it < 5; ++it) {
        const int pc = wid + 8 * it;
        const unsigned m0v = rflu(lds0 + (unsigned)(slot * AT_STAGE + pc * 1024));
        if (it < 3) bdma16(m0v, (unsigned)lane * 16u, srdK, rflu(koff + (unsigned)pc * 1024u));
        else bdma16(m0v, (unsigned)lane * 16u, srdV, rflu(voffs + (unsigned)(pc - 24) * 1024u));
    }
}
__device__ __forceinline__ void attn_unit(unsigned char* lds, const Params& p, int head, int tok0, int S, int qblk) {
    const int tid = threadIdx.x, lane = tid & 63, wid = __builtin_amdgcn_readfirstlane(tid >> 6), r32 = lane & 31, hi = lane >> 5;
    const unsigned lds0 = rflu((unsigned)(uintptr_t)lds);
    const int tq0 = tok0 + qblk * 256 + wid * 32;
    const srd_t srdK = make_srd(p.ws + WS_KF), srdV = make_srd(p.ws + WS_VF);
    const unsigned koff0 = (unsigned)(head * NBLK32 + (tok0 >> 5)) * 3072u;
    const unsigned voff0 = (unsigned)(head * (NTOK / 64) + (tok0 >> 6)) * 4096u;
    const int NU = S / 256;
    attn_dma(lds0, 0, srdK, srdV, koff0, voff0, wid, lane);
    attn_dma(lds0, 1, srdK, srdV, koff0 + 24576u, voff0 + 16384u, wid, lane);
    u32x4 q0, q1, q2;
    { const unsigned char* qp = p.ws + WS_QF + (size_t)(head * NBLK32 + (tq0 >> 5)) * 3072 + lane * 16;
      q0 = *(const u32x4*)qp; q1 = *(const u32x4*)(qp + 1024); q2 = *(const u32x4*)(qp + 2048); }
    const u32x4 zz = {0u, 0u, 0u, 0u};
    f32x16 o0, o1, negm;
#pragma unroll
    for (int r = 0; r < 16; ++r) { o0[r] = 0.f; o1[r] = 0.f; negm[r] = 0.f; }
    AT_PIN(negm);
    float mref = 0.f;
    f32x16 lacc;
#pragma unroll
    for (int r = 0; r < 16; ++r) lacc[r] = 0.f;
    const u32x4 ones8 = {0x38383838u, 0x38383838u, 0x38383838u, 0x38383838u};
    AT_WAIT_BAR(5);
    int slot = 0;
    for (int u = 0; u < NU; ++u) {
        const bool pf = u + 2 < NU;
        const int s2 = slot == 0 ? 2 : slot - 1;
#pragma unroll
        for (int h = 0; h < 4; ++h) {
            if (pf && (wid & 3) == h) attn_dma(lds0, s2, srdK, srdV, koff0 + (unsigned)(u + 2) * 24576u, voff0 + (unsigned)(u + 2) * 16384u, wid, lane);
            const unsigned char* kb = lds + slot * AT_STAGE + h * 6144 + lane * 16;
            const unsigned char* vb = lds + slot * AT_STAGE + 24576 + h * 4096 + lane * 16;
            f32x16 s0, s1;
            { const u32x4 a0 = *(const u32x4*)(kb), a1 = *(const u32x4*)(kb + 1024), a2 = *(const u32x4*)(kb + 2048);
              const u32x4 b0 = *(const u32x4*)(kb + 3072), b1 = *(const u32x4*)(kb + 4096), b2 = *(const u32x4*)(kb + 5120);
              s0 = mfma8(a0, a1, q0, q1, negm); s1 = mfma8(b0, b1, q0, q1, negm);
              s0 = mfma8(a2, zz, q2, zz, s0);   s1 = mfma8(b2, zz, q2, zz, s1); }
            asm volatile("s_nop 15\n\ts_nop 15" : "+v"(s0), "+v"(s1));
            float ma = max3f(s0[0], s0[1], s1[0]), mb = max3f(s0[2], s0[3], s1[1]); ma = max3f(ma, s1[2], s1[3]);
#pragma unroll
            for (int r = 4; r < 16; r += 4) { ma = max3f(ma, s0[r], s0[r + 1]); mb = max3f(mb, s0[r + 2], s0[r + 3]); ma = max3f(ma, s1[r], s1[r + 1]); mb = max3f(mb, s1[r + 2], s1[r + 3]); }
            float mx = max2f_pad(ma, mb);
            { auto rr = __builtin_amdgcn_permlane32_swap(__float_as_uint(mx), __float_as_uint(mx), false, false); mx = fmaxf(__uint_as_float(rr[0]), __uint_as_float(rr[1])); }
            const bool first = (u == 0) && (h == 0);
            if (__builtin_expect(first || __any(mx > 7.5f), 0)) {
                const float d = first ? mx - 6.f : fmaxf(mx - 6.f, 0.f);
                mref += d;
                const float f = __builtin_amdgcn_exp2f(-d);
#pragma unroll
                for (int r = 0; r < 16; ++r) { s0[r] -= d; s1[r] -= d; o0[r] *= f; o1[r] *= f; lacc[r] *= f; negm[r] = -mref; }
                AT_PIN(negm);
            }
#pragma unroll
            for (int r = 0; r < 16; ++r) { s0[r] = __builtin_amdgcn_exp2f(s0[r]); s1[r] = __builtin_amdgcn_exp2f(s1[r]); }
            float pv0[16], pv1[16];
#pragma unroll
            for (int r = 0; r < 16; ++r) { pv0[r] = s0[r]; pv1[r] = s1[r]; }
            const u32x4 p0 = pack16_fp8(pv0), p1 = pack16_fp8(pv1);
            { const u32x4 v00 = *(const u32x4*)(vb), v01 = *(const u32x4*)(vb + 1024), v10 = *(const u32x4*)(vb + 2048), v11 = *(const u32x4*)(vb + 3072);
              o0 = mfma8(v00, v01, p0, p1, o0); o1 = mfma8(v10, v11, p0, p1, o1); lacc = mfma8(ones8, ones8, p0, p1, lacc); }
        }
        if (pf) AT_WAIT_BAR(5); else AT_WAIT_BAR(0);
        slot = slot == 2 ? 0 : slot + 1;
    }
    const float inv = 1.f / lacc[0];
    const int tok = tq0 + r32;
    const bf16_t* sz = (const bf16_t*)(p.ws + WS_SZ) + (size_t)tok * AW + head * 64 + 8 * hi;
    bf16_t* mo = (bf16_t*)(p.ws + WS_MIX2) + (size_t)tok * AW + head * 64 + 8 * hi;
#pragma unroll
    for (int d0 = 0; d0 < 2; ++d0)
#pragma unroll
        for (int q8 = 0; q8 < 2; ++q8) {
            const u32x4 g = *(const u32x4*)(sz + 32 * d0 + 16 * q8);
            float v[8];
#pragma unroll
            for (int e = 0; e < 4; ++e) {
                const float a = d0 == 0 ? o0[8 * q8 + 2 * e] : o1[8 * q8 + 2 * e], b = d0 == 0 ? o0[8 * q8 + 2 * e + 1] : o1[8 * q8 + 2 * e + 1];
                v[2 * e] = a * inv * bf_lo(g[e]); v[2 * e + 1] = b * inv * bf_hi(g[e]);
            }
            *(u32x4*)(mo + 32 * d0 + 16 * q8) = pack8(v);
        }
}


constexpr size_t WS_BAR = 640 * 1024;
#define XB_TMO      128
#define XB_XCNT(j)  (256  + 64 * (j))
#define XB_XSUB(j)  (1280 + 64 * (j))
#define XB_XGEN(j)  (2304 + 64 * (j))
#define XB_TOP      3328
#define XB_TOPGEN   3392
#define XCD_BAR_WORDS 3456
#define XB_SPIN_CAP (1u << 18)
__device__ __forceinline__ unsigned xb_ld(unsigned* p)              { return __hip_atomic_load(p, __ATOMIC_RELAXED, __HIP_MEMORY_SCOPE_AGENT); }
__device__ __forceinline__ unsigned xb_add(unsigned* p, unsigned v) { return __hip_atomic_fetch_add(p, v, __ATOMIC_RELAXED, __HIP_MEMORY_SCOPE_AGENT); }
__device__ __forceinline__ unsigned xb_xcc_id() { return (unsigned)__builtin_amdgcn_s_getreg((3 << 11) | 20) & 0xFu; }
#define XB_SPIN(cond, bar) do { unsigned _sp = 0; while (cond) { __builtin_amdgcn_s_sleep(1); \
    if ((++_sp & 255u) == 0u) { if (xb_ld(&(bar)[XB_TMO])) break; if (_sp > XB_SPIN_CAP) { atomicAdd(&(bar)[XB_TMO], 1u); break; } } } } while (0)
struct XcdBarrier { unsigned* bar; unsigned x; unsigned nloc, nx; };
__device__ __forceinline__ XcdBarrier xcd_barrier_post(unsigned* bar) {
    XcdBarrier b; b.bar = bar; b.x = xb_xcc_id(); b.nloc = 0u; b.nx = 0u;
    if (threadIdx.x == 0) (void)xb_add(&bar[XB_XCNT(b.x)], 1u);
    return b;
}
__device__ __forceinline__ void xcd_barrier_complete(unsigned* bar, unsigned x, unsigned& nloc, unsigned& nx) {
    const unsigned G = gridDim.x * gridDim.y * gridDim.z;
    unsigned sum, cnt, mine, sp = 0u;
    for (;;) {
        sum = 0u; cnt = 0u; mine = 0u;
#pragma unroll
        for (unsigned j = 0; j < 16; ++j) { const unsigned c = xb_ld(&bar[XB_XCNT(j)]); sum += c; cnt += (c > 0u) ? 1u : 0u; mine = (j == x) ? c : mine; }
        if (sum == G) break;
        __builtin_amdgcn_s_sleep(1);
        if ((++sp & 255u) == 0u) { if (xb_ld(&bar[XB_TMO])) break; if (sp > XB_SPIN_CAP) { atomicAdd(&bar[XB_TMO], 1u); break; } }
    }
    nloc = mine > 0u ? mine : 1u; nx = cnt > 0u ? cnt : 1u;
}
__device__ __forceinline__ void xcd_barrier(XcdBarrier& b) {
    asm volatile("s_waitcnt vmcnt(0)" ::: "memory");
    __syncthreads();
    if (threadIdx.x == 0) {
        unsigned* bar = b.bar;
        __builtin_amdgcn_s_waitcnt(0);
        unsigned nloc = b.nloc, nx = b.nx;
        if (nloc == 0u) { xcd_barrier_complete(bar, b.x, nloc, nx); b.nloc = nloc; b.nx = nx; }
        const unsigned old = xb_add(&bar[XB_XSUB(b.x)], 1u);
        const unsigned gen = old / nloc;
        if (old + 1u == (gen + 1u) * nloc) {
            __builtin_amdgcn_fence(__ATOMIC_RELEASE, "agent");
            asm volatile("s_waitcnt vmcnt(0)" ::: "memory");
            const unsigned og = xb_add(&bar[XB_TOP], 1u);
            const unsigned tg = og / nx;
            if (og + 1u == (tg + 1u) * nx) xb_add(&bar[XB_TOPGEN], 1u);
            else XB_SPIN(xb_ld(&bar[XB_TOPGEN]) == tg, bar);
            __builtin_amdgcn_fence(__ATOMIC_ACQUIRE, "agent");
            xb_add(&bar[XB_XGEN(b.x)], 1u);
            asm volatile("s_waitcnt vmcnt(0)" ::: "memory");
        } else {
            XB_SPIN(xb_ld(&bar[XB_XGEN(b.x)]) == gen, bar);
            __builtin_amdgcn_fence(__ATOMIC_ACQUIRE, "agent");
            asm volatile("s_waitcnt vmcnt(0)" ::: "memory");
        }
    }
    __syncthreads();
}

__global__ void __launch_bounds__(NTHR, 2) fwd_kernel(Params p) {
    extern __shared__ __attribute__((aligned(16))) unsigned char lds[];
    cg::grid_group grid = cg::this_grid();
    const int G = gridDim.x, bx = blockIdx.x, tid = threadIdx.x;
    const int gtid = bx * NTHR + tid, gthreads = G * NTHR;
    const int xcd = bx & 7, lb = bx >> 3, GX = G >> 3;
    unsigned char* ws = p.ws;

    __syncthreads();
    XcdBarrier xbar = xcd_barrier_post((unsigned*)(ws + WS_BAR));
    if (p.ws == nullptr) grid.sync();
    phase0(p, gtid, gthreads);
    xcd_barrier(xbar);

    { EpiIn E{ws}; const bf16_t* xn = (const bf16_t*)(ws + WS_XN); const bf16_t* W = (const bf16_t*)(ws + WS_WIN);
      gemm_dma<4, 2, 0>(lds, xn, xn, 1 << 30, DM, W, DM, 13, xcd, lb, GX, E); }
    xcd_barrier(xbar);

    { EpiQ E{ws}; const bf16_t* A = (const bf16_t*)(ws + WS_QLAT); const bf16_t* W = (const bf16_t*)(ws + WS_WUQ);
      gemm_dma<2, 3, 0>(lds, A, A, 1 << 30, QLR, W, QLR, 2, xcd, lb, GX, E); }
    { EpiKV E{ws}; const bf16_t* A = (const bf16_t*)(ws + WS_KVLAT); const bf16_t* W = (const bf16_t*)(ws + WS_WUKV);
      gemm_dma<4, 2, 1>(lds, A, A, 1 << 30, KVLR, W, KVLR, 4, xcd, lb, GX, E); }
    conv_phase(p, gtid, gthreads);
    xcd_barrier(xbar);

    for (int w = lb; w < 128; w += GX) { const int bl = w >> 6, qblk = w & 63; attn_unit(lds, p, xcd, NTOK_P + bl * SEQ_S, SEQ_S, qblk); }
    { unsigned* tick = (unsigned*)(ws + WS_BAR) + 3584 + 64 * xcd;
      for (;;) {
          if (tid == 0) *(volatile unsigned*)lds = xb_add(tick, 1u);
          __syncthreads();
          const unsigned w2 = *(volatile unsigned*)lds;
          __syncthreads();
          if (w2 >= 64u) break;
          attn_unit(lds, p, (int)(w2 >> 3), xcd * SEQ_P, SEQ_P, (int)(w2 & 7));
      } }
    xcd_barrier(xbar);

    { EpiOut E{ws}; const bf16_t* A0 = (const bf16_t*)(ws + WS_MIXA); const bf16_t* A1 = (const bf16_t*)(ws + WS_MIX2); const bf16_t* W = (const bf16_t*)(ws + WS_WOUT);
      gemm_dma<4, 2, 0>(lds, A0, A1, 512, CW, W, DM, 4, xcd, lb, GX, E); }
    xcd_barrier(xbar);

    { const float* ssq = (const float*)(ws + WS_SSQ) + 2 * NTOK; const bf16_t* ob = (const bf16_t*)(ws + WS_XN);
      const int lane = tid & 63, gw = gtid >> 6, nw = gthreads >> 6;
      f32x4 g[4];
#pragma unroll
      for (int j = 0; j < 4; ++j) g[j] = *(const f32x4*)(p.norm_post + 4 * lane + 256 * j);
      for (int row = gw * 2; row < NTOK; row += nw * 2) {
          f32x4 xv[2][4]; u32x2 ov[2][4]; float rs[2];
#pragma unroll
          for (int u = 0; u < 2; ++u) {
              const float* xr = xrow(p, row + u) + 4 * lane; const bf16_t* orow = ob + (size_t)(row + u) * DM + 4 * lane;
#pragma unroll
              for (int j = 0; j < 4; ++j) { xv[u][j] = *(const f32x4*)(xr + 256 * j); ov[u][j] = *(const u32x2*)(orow + 256 * j); }
              rs[u] = rsqrtf(ssq[row + u] * (1.f / DM) + EPS);
          }
#pragma unroll
          for (int u = 0; u < 2; ++u) {
              float* yr = p.out + (size_t)(row + u) * DM + 4 * lane;
#pragma unroll
              for (int j = 0; j < 4; ++j) {
                  f32x4 o; o.x = bf_lo(ov[u][j].x); o.y = bf_hi(ov[u][j].x); o.z = bf_lo(ov[u][j].y); o.w = bf_hi(ov[u][j].y);
                  *(f32x4*)(yr + 256 * j) = xv[u][j] + o * rs[u] * g[j];
              }
          }
      } }
}

extern "C" void kernel_launch(void* const* d_in, const int* in_sizes, int n_in, void* d_out, int out_size, void* d_ws, size_t ws_size, hipStream_t stream) {
    static int grid_blocks = 0;
    if (!grid_blocks) {
        int dev = 0, cus = 0, per_cu = 0;
        hipGetDevice(&dev);
        hipDeviceGetAttribute(&cus, hipDeviceAttributeMultiprocessorCount, dev);
        hipFuncSetAttribute((const void*)fwd_kernel, hipFuncAttributeMaxDynamicSharedMemorySize, LDS_BYTES);
        hipOccupancyMaxActiveBlocksPerMultiprocessor(&per_cu, (const void*)fwd_kernel, NTHR, LDS_BYTES);
        if (per_cu < 1) per_cu = 1;
        if (per_cu > 1) per_cu = 1;
        grid_blocks = cus * per_cu;
        if (ws_size < WS_END) fprintf(stderr, "kernel_launch: workspace too small (%zu < %zu)\n", ws_size, (size_t)WS_END);
    }
    (void)hipMemsetAsync((unsigned char*)d_ws + WS_BAR, 0, 16384, stream);
    Params p{};
    p.x_prompt = (const float*)d_in[0]; p.x_sample = (const float*)d_in[1]; p.norm_pre = (const float*)d_in[2]; p.w_in = (const float*)d_in[3];
    p.conv_w = (const float*)d_in[4]; p.q_norm = (const float*)d_in[5]; p.w_uq = (const float*)d_in[6]; p.kv_norm = (const float*)d_in[7];
    p.w_ukv = (const float*)d_in[8]; p.w_out = (const float*)d_in[9]; p.norm_post = (const float*)d_in[10];
    p.out = (float*)d_out; p.ws = (unsigned char*)d_ws;
    void* args[] = {&p};
    hipError_t e = hipLaunchCooperativeKernel((const void*)fwd_kernel, dim3(grid_blocks), dim3(NTHR), args, LDS_BYTES, stream);
    if (e != hipSuccess) fprintf(stderr, "cooperative launch failed: %s (grid %d)\n", hipGetErrorString(e), grid_blocks);
}
```

```cpp
#include <hip/hip_runtime.h>
#include <hip/hip_cooperative_groups.h>
#include <cstdio>
#include <cstdint>
namespace cg = cooperative_groups;

typedef unsigned short bf16_t;
typedef short bf16x8 __attribute__((ext_vector_type(8)));
typedef float f32x16 __attribute__((ext_vector_type(16)));
typedef float f32x4 __attribute__((ext_vector_type(4)));
typedef float f32x2 __attribute__((ext_vector_type(2)));
typedef unsigned u32x4 __attribute__((ext_vector_type(4)));
typedef unsigned u32x2 __attribute__((ext_vector_type(2)));
#define LAS __attribute__((address_space(3)))

constexpr int DM = 1024, NTOK = 49152, NTOK_P = 16384, SEQ_P = 2048, SEQ_S = 16384;
constexpr int CW = 512, NH = 8, QLR = 384, KVLR = 256, ROPE = 32, AW = 512;
constexpr int NIN = 3328;
constexpr int NBLK32 = NTOK / 32;
constexpr float EPS = 1e-6f;
constexpr float C2 = 0.14724444f;

constexpr size_t MiB = 1u << 20;
constexpr size_t WS_SSQ = 0;
constexpr size_t WS_COS = 1 * MiB, WS_SIN = 2 * MiB;
constexpr size_t WS_WIN = 3 * MiB;
constexpr size_t WS_WUQ = 10 * MiB;
constexpr size_t WS_WUKV = 11 * MiB;
constexpr size_t WS_WOUT = 12 * MiB;
constexpr size_t WS_XN = 16 * MiB;
constexpr size_t WS_QF = 16 * MiB;
constexpr size_t WS_CU = 112 * MiB;
constexpr size_t WS_GZ = 160 * MiB;
constexpr size_t WS_SZ = 208 * MiB;
constexpr size_t WS_QLAT = 256 * MiB;
constexpr size_t WS_KVLAT = 292 * MiB;
constexpr size_t WS_MIX2 = 256 * MiB;
constexpr size_t WS_KF = 316 * MiB;
constexpr size_t WS_VF = 388 * MiB;
constexpr size_t WS_MIXA = 436 * MiB;
constexpr size_t WS_END = 484 * MiB;

constexpr int LDS_BYTES = 131072;
constexpr int NTHR = 512;

struct Params {
    const float* x_prompt; const float* x_sample; const float* norm_pre; const float* w_in; const float* conv_w;
    const float* q_norm; const float* w_uq; const float* kv_norm; const float* w_ukv; const float* w_out; const float* norm_post;
    float* out; unsigned char* ws;
};

__device__ __forceinline__ unsigned pk_bf16(float lo, float hi) {
    typedef __bf16 b2 __attribute__((ext_vector_type(2)));
    f32x2 v = {lo, hi}; b2 b = __builtin_convertvector(v, b2); return __builtin_bit_cast(unsigned, b);
}
__device__ __forceinline__ float bf_lo(unsigned u) { return __uint_as_float(u << 16); }
__device__ __forceinline__ float bf_hi(unsigned u) { return __uint_as_float(u & 0xffff0000u); }
__device__ __forceinline__ u32x4 pack8(const float* v) {
    u32x4 w; w.x = pk_bf16(v[0], v[1]); w.y = pk_bf16(v[2], v[3]); w.z = pk_bf16(v[4], v[5]); w.w = pk_bf16(v[6], v[7]); return w;
}
typedef int i32x8 __attribute__((ext_vector_type(8)));
__device__ __forceinline__ u32x4 pack16_fp8(const float* v) {
    u32x4 w;
#pragma unroll
    for (int k = 0; k < 4; ++k) { int t = __builtin_amdgcn_cvt_pk_fp8_f32(v[4 * k], v[4 * k + 1], 0, false); t = __builtin_amdgcn_cvt_pk_fp8_f32(v[4 * k + 2], v[4 * k + 3], t, true); w[k] = (unsigned)t; }
    return w;
}
__device__ __forceinline__ f32x16 mfma8(u32x4 a0, u32x4 a1, u32x4 b0, u32x4 b1, f32x16 c) {
    const i32x8 A = {(int)a0.x, (int)a0.y, (int)a0.z, (int)a0.w, (int)a1.x, (int)a1.y, (int)a1.z, (int)a1.w};
    const i32x8 B = {(int)b0.x, (int)b0.y, (int)b0.z, (int)b0.w, (int)b1.x, (int)b1.y, (int)b1.z, (int)b1.w};
    return __builtin_amdgcn_mfma_scale_f32_32x32x64_f8f6f4(A, B, c, 0, 0, 0, 0x7f7f7f7f, 0, 0x7f7f7f7f);
}
__device__ __forceinline__ f32x16 mfma8v(i32x8 A, i32x8 B, f32x16 c) { return __builtin_amdgcn_mfma_scale_f32_32x32x64_f8f6f4(A, B, c, 0, 0, 0, 0x7f7f7f7f, 0, 0x7f7f7f7f); }
__device__ __forceinline__ void pack32_fp8_into(i32x8& P, const f32x16& s0, const f32x16& s1) {
#pragma unroll
    for (int k = 0; k < 4; ++k) { int t = __builtin_amdgcn_cvt_pk_fp8_f32(s0[4 * k], s0[4 * k + 1], P[k], false); P[k] = __builtin_amdgcn_cvt_pk_fp8_f32(s0[4 * k + 2], s0[4 * k + 3], t, true); }
#pragma unroll
    for (int k = 0; k < 4; ++k) { int t = __builtin_amdgcn_cvt_pk_fp8_f32(s1[4 * k], s1[4 * k + 1], P[4 + k], false); P[4 + k] = __builtin_amdgcn_cvt_pk_fp8_f32(s1[4 * k + 2], s1[4 * k + 3], t, true); }
}
__device__ __forceinline__ float silu_f(float z) { return z / (1.f + __expf(-z)); }
__device__ __forceinline__ int cperm(int p) { const int hp = (p >> 2) & 1, r = (p & 3) + 4 * (p >> 3); return 16 * (r >> 3) + 8 * hp + (r & 7); }
__device__ __forceinline__ int crow(int r, int hi) { return (r & 3) + 8 * (r >> 2) + 4 * hi; }
__device__ __forceinline__ float swap32_max(float m) {
    auto rr = __builtin_amdgcn_permlane32_swap(__float_as_uint(m), __float_as_uint(m), false, false);
    return fmaxf(__uint_as_float(rr[0]), __uint_as_float(rr[1]));
}
__device__ __forceinline__ float swap32_sum(float m) {
    auto rr = __builtin_amdgcn_permlane32_swap(__float_as_uint(m), __float_as_uint(m), false, false);
    return __uint_as_float(rr[0]) + __uint_as_float(rr[1]);
}
__device__ __forceinline__ float wave_sum(float v) {
#pragma unroll
    for (int o = 1; o < 64; o <<= 1) v += __shfl_xor(v, o);
    return v;
}
__device__ __forceinline__ const float* xrow(const Params& p, int tok) {
    return tok < NTOK_P ? p.x_prompt + (size_t)tok * DM : p.x_sample + (size_t)(tok - NTOK_P) * DM;
}
__device__ __forceinline__ int tok_pos(int tok) { return tok < NTOK_P ? (tok & (SEQ_P - 1)) : (tok & (SEQ_S - 1)); }

__device__ __forceinline__ void glds16(const void* gsrc, unsigned lds_dst) {
    unsigned keep;
    asm volatile("s_mov_b32 %0, m0\n\ts_mov_b32 m0, %2\n\ts_nop 0\n\tglobal_load_lds_dwordx4 %1, off\n\ts_mov_b32 m0, %0" : "=&s"(keep) : "v"(gsrc), "s"(lds_dst) : "memory");
}
#define AT_WAIT_BAR(N) asm volatile("s_waitcnt vmcnt(" #N ") lgkmcnt(0)\n\ts_barrier" ::: "memory")
typedef __amdgpu_buffer_rsrc_t srd_t;
__device__ __forceinline__ srd_t make_srd(const void* base) { return __builtin_amdgcn_make_buffer_rsrc((void*)base, (short)0, 0x7ffffffe, 0x00020000); }
__device__ __forceinline__ void bdma16(unsigned m0v, unsigned voff, srd_t srd, unsigned soff) {
    asm volatile("s_nop 4\n\ts_mov_b32 m0, %0\n\ts_nop 0\n\tbuffer_load_dwordx4 %1, %2, %3 offen lds" :: "s"(m0v), "v"(voff), "s"(srd), "s"(soff) : "m0", "memory");
}
__device__ __forceinline__ unsigned rflu(unsigned v) { return (unsigned)__builtin_amdgcn_readfirstlane((int)v); }

__device__ __forceinline__ int win_src(int np) {
    const int T = np >> 7, w = np & 127;
    if (T < 16) { const int wn = w >> 6, j = (w >> 5) & 1, q = (w >> 4) & 1, i16 = w & 15; return (2 * j + q) * 512 + 32 * T + 16 * wn + i16; }
    if (T < 21) return np;
    if (T < 25) return 2720 + (np - 2688);
    return w < 32 ? 2688 + w : -1;
}
template <int MODE>
__device__ __forceinline__ void prep_weight(const float* __restrict__ w, const float* __restrict__ gain, bf16_t* WT, int K, int Nsrc, int Ndst, int gtid, int gthreads) {
    const int items = Ndst * (K / 8);
    for (int id = gtid; id < items; id += gthreads) {
        const int n = id % Ndst, kc = id / Ndst, k0 = kc * 8;
        const int src = (MODE == 1) ? win_src(n) : n;
        float v[8];
#pragma unroll
        for (int e = 0; e < 8; ++e) v[e] = (src >= 0) ? w[(size_t)(k0 + e) * Nsrc + src] * (gain ? gain[k0 + e] : 1.f) : 0.f;
        *(u32x4*)(WT + (size_t)n * K + k0) = pack8(v);
    }
}
__device__ __forceinline__ void rope_entry(int pos, int i, float& c, float& s) {
    const int a = i & 3, b = i >> 2;
    double base = a == 0 ? 1.0 : a == 1 ? 0.5623413251903491 : a == 2 ? 0.31622776601683794 : 0.1778279410038923;
    double sc = b == 0 ? 1.0 : b == 1 ? 0.1 : b == 2 ? 0.01 : 0.001;
    const float freq = (float)(base * sc);
    const float angf = (float)pos * freq;
    const double x = (double)angf;
    const double kq = rint(x * 0.6366197723675814);
    const double r = (x - kq * 1.5707963267948966) - kq * 6.123233995736766e-17;
    const double r2 = r * r;
    const double sn = r * (1.0 + r2 * (-1.0 / 6 + r2 * (1.0 / 120 + r2 * (-1.0 / 5040 + r2 * (1.0 / 362880 + r2 * (-1.0 / 39916800))))));
    const double cs = 1.0 + r2 * (-0.5 + r2 * (1.0 / 24 + r2 * (-1.0 / 720 + r2 * (1.0 / 40320 + r2 * (-1.0 / 3628800 + r2 * (1.0 / 479001600))))));
    const int qd = ((int)kq) & 3;
    const double so = qd == 0 ? sn : qd == 1 ? cs : qd == 2 ? -sn : -cs;
    const double co = qd == 0 ? cs : qd == 1 ? -sn : qd == 2 ? -cs : sn;
    c = (float)co; s = (float)so;
}
__device__ __forceinline__ void phase0(const Params& p, int gtid, int gthreads) {
    unsigned char* ws = p.ws;
    float* ssq = (float*)(ws + WS_SSQ);
    for (int i = gtid; i < 3 * NTOK; i += gthreads) ssq[i] = 0.f;
    float* ct = (float*)(ws + WS_COS); float* st = (float*)(ws + WS_SIN);
    for (int i = gtid; i < SEQ_S * 16; i += gthreads) { float c, s; rope_entry(i >> 4, i & 15, c, s); ct[i] = c; st[i] = s; }
    prep_weight<1>(p.w_in, p.norm_pre, (bf16_t*)(ws + WS_WIN), DM, 3232, NIN, gtid, gthreads);
    prep_weight<0>(p.w_uq, p.q_norm, (bf16_t*)(ws + WS_WUQ), QLR, 768, 768, gtid, gthreads);
    prep_weight<0>(p.w_ukv, p.kv_norm, (bf16_t*)(ws + WS_WUKV), KVLR, 1024, 1024, gtid, gthreads);
    prep_weight<0>(p.w_out, nullptr, (bf16_t*)(ws + WS_WOUT), DM, 1024, 1024, gtid, gthreads);
    const int gw = gtid >> 6, nw = gthreads >> 6, lane = threadIdx.x & 63;
    bf16_t* xn = (bf16_t*)(ws + WS_XN);
    for (int row = gw * 2; row < NTOK; row += nw * 2) {
        f32x4 v[2][4]; float s[2];
#pragma unroll
        for (int u = 0; u < 2; ++u) {
            const f32x4* xr = (const f32x4*)xrow(p, row + u) + lane; s[u] = 0.f;
#pragma unroll
            for (int j = 0; j < 4; ++j) { v[u][j] = xr[64 * j]; }
        }
#pragma unroll
        for (int u = 0; u < 2; ++u) {
#pragma unroll
            for (int j = 0; j < 4; ++j) s[u] += (v[u][j].x * v[u][j].x + v[u][j].y * v[u][j].y) + (v[u][j].z * v[u][j].z + v[u][j].w * v[u][j].w);
            const float rs = rsqrtf(wave_sum(s[u]) * (1.f / DM) + EPS);
            u32x2* o = (u32x2*)(xn + (size_t)(row + u) * DM) + lane;
#pragma unroll
            for (int j = 0; j < 4; ++j) { u32x2 w; w.x = pk_bf16(v[u][j].x * rs, v[u][j].y * rs); w.y = pk_bf16(v[u][j].z * rs, v[u][j].w * rs); o[64 * j] = w; }
        }
    }
}

__device__ __forceinline__ void tile_map(int w, int NT, int xcd, int MPX, int& mt, int& nt) {
    const int g = w / (8 * NT), rem = w % (8 * NT);
    nt = rem >> 3; mt = xcd * MPX + g * 8 + (rem & 7);
}
template <int MI, int NJ, int MODE, class Epi>
__device__ __forceinline__ void gemm_dma(unsigned char* lds, const bf16_t* __restrict__ A0, const bf16_t* __restrict__ A1, int ksplit, int lda,
                                         const bf16_t* __restrict__ Bt, int K, int NT, int xcd, int lb, int GX, const Epi& epi) {
    constexpr int NSA = 4 * MI, NSUB = 4 * MI + 8 * NJ, STAGE = NSUB * 1024, NIT = NSUB / 8, NITA = NSA / 8, BOFF = NSA * 1024, MPX = 96 / MI;
    static_assert(4 * STAGE <= LDS_BYTES && NSUB % 8 == 0 && NSA % 8 == 0, "lds");
    const int tid = threadIdx.x, lane = tid & 63, wid = __builtin_amdgcn_readfirstlane(tid >> 6), wm = wid >> 2, wn = wid & 3;
    const int r32 = lane & 31, hi = lane >> 5;
    const unsigned lds0 = rflu((unsigned)(uintptr_t)lds);
    const int nk = K / 32, count = MPX * NT;
    int w = lb;
    if (w >= count) return;
    int mt, nt; tile_map(w, NT, xcd, MPX, mt, nt);
    const int rowl = lane >> 2, colsw = 8 * ((lane & 3) ^ ((lane >> 4) & 3));
    const unsigned voffA = (unsigned)((rowl * lda + colsw) * 2), voffB = (unsigned)((rowl * K + colsw) * 2);
    const srd_t srdA0 = make_srd(A0), srdA1 = make_srd(A1), srdB = make_srd(Bt);
    auto dma = [&](int tmt, int tnt, int kt, int stage) {
        const int k0 = kt * 32;
        const bool lo = k0 < ksplit;
        const unsigned sa = (unsigned)(tmt * 64 * MI) * (unsigned)(lda * 2) + (unsigned)((lo ? k0 : k0 - ksplit) * 2);
        const unsigned sbb = (unsigned)(tnt * 128 * NJ) * (unsigned)(K * 2) + (unsigned)(k0 * 2);
#pragma unroll
        for (int it = 0; it < NIT; ++it) {
            const int f = wid + 8 * it;
            const unsigned m0v = rflu(lds0 + (unsigned)(stage * STAGE + f * 1024));
            if (it < NITA) { const unsigned so = rflu(sa + (unsigned)(f * 16) * (unsigned)(lda * 2)); if (lo) bdma16(m0v, voffA, srdA0, so); else bdma16(m0v, voffA, srdA1, so); }
            else { const unsigned so = rflu(sbb + (unsigned)((f - NSA) * 16) * (unsigned)(K * 2)); bdma16(m0v, voffB, srdB, so); }
        }
    };
    const int cb = cperm(r32);
    const int arow = (wm * 32 * MI + r32), brow = (wn * 32 * NJ + cb);
    const int abase = (arow >> 4) * 1024 + (arow & 15) * 64, ax = (arow >> 2) & 3;
    const int bbase = BOFF + (brow >> 4) * 1024 + (brow & 15) * 64, bx_ = (brow >> 2) & 3;
    const bool swp = (MODE == 0) || ((wn & 1) == 0);
    f32x16 acc[MI][NJ];
    auto compute = [&](int stage) {
        const unsigned char* base = lds + stage * STAGE;
#pragma unroll
        for (int kk = 0; kk < 2; ++kk) {
            bf16x8 af[MI], bfr[NJ];
            const int ca = ((2 * kk + hi) ^ ax) << 4, cbb = ((2 * kk + hi) ^ bx_) << 4;
#pragma unroll
            for (int i = 0; i < MI; ++i) af[i] = *(const bf16x8*)(base + abase + i * 2048 + ca);
#pragma unroll
            for (int j = 0; j < NJ; ++j) bfr[j] = *(const bf16x8*)(base + bbase + j * 2048 + cbb);
#pragma unroll
            for (int i = 0; i < MI; ++i)
#pragma unroll
                for (int j = 0; j < NJ; ++j) {
                    if (MODE == 0) acc[i][j] = __builtin_amdgcn_mfma_f32_32x32x16_bf16(bfr[j], af[i], acc[i][j], 0, 0, 0);
                    else { const bf16x8 xa = swp ? bfr[j] : af[i], xb = swp ? af[i] : bfr[j]; acc[i][j] = __builtin_amdgcn_mfma_f32_32x32x16_bf16(xa, xb, acc[i][j], 0, 0, 0); }
                }
        }
    };
    auto dma2 = [&](int tmt, int tnt, int kt2, int sb) { dma(tmt, tnt, 2 * kt2, 2 * sb); dma(tmt, tnt, 2 * kt2 + 1, 2 * sb + 1); };
    dma2(mt, nt, 0, 0);
    int sb = 0;
    const int nk2 = nk >> 1;
    for (;;) {
        const int wnx = w + GX; const bool has_next = wnx < count;
        int mt2 = mt, nt2 = nt; if (has_next) tile_map(wnx, NT, xcd, MPX, mt2, nt2);
#pragma unroll
        for (int i = 0; i < MI; ++i)
#pragma unroll
            for (int j = 0; j < NJ; ++j)
#pragma unroll
                for (int r = 0; r < 16; ++r) acc[i][j][r] = 0.f;
        AT_WAIT_BAR(0);
        for (int kt2 = 0; kt2 < nk2; ++kt2) {
            const bool last = kt2 + 1 == nk2;
            if (wm == 0) { if (!last) dma2(mt, nt, kt2 + 1, sb ^ 1); else if (has_next) dma2(mt2, nt2, 0, sb ^ 1); }
            compute(2 * sb);
            if (wm != 0) { if (!last) dma2(mt, nt, kt2 + 1, sb ^ 1); else if (has_next) dma2(mt2, nt2, 0, sb ^ 1); }
            compute(2 * sb + 1);
            if (!last) AT_WAIT_BAR(0);
            sb ^= 1;
        }
        epi(acc, mt, nt * 2 + (wn >> 1), wm, wn & 1, r32, hi);
        if (!has_next) break;
        w = wnx; mt = mt2; nt = nt2;
    }
    AT_WAIT_BAR(0);
}

struct EpiIn {
    unsigned char* ws;
    template <int MI> __device__ __forceinline__ void operator()(f32x16 (&acc)[MI][2], int mt, int nt, int wm, int wn, int r32, int hi) const {
        const int lane = r32 + 32 * hi;
        if (nt < 16) {
            bf16_t* cu = (bf16_t*)(ws + WS_CU); bf16_t* gz = (bf16_t*)(ws + WS_GZ);
#pragma unroll
            for (int i = 0; i < MI; ++i) {
                const int tok = mt * (64 * MI) + wm * (32 * MI) + 32 * i + r32; const int ch0 = 32 * nt + 16 * wn + 8 * hi;
                float a[8], b[8];
#pragma unroll
                for (int e = 0; e < 8; ++e) { const float u = acc[i][0][e], B = acc[i][0][8 + e], C = acc[i][1][e], z = acc[i][1][8 + e]; a[e] = C * u; b[e] = B * silu_f(z); }
                *(u32x4*)(cu + (size_t)tok * CW + ch0) = pack8(a);
                *(u32x4*)(gz + (size_t)tok * CW + ch0) = pack8(b);
            }
        } else if (nt < 21) {
            const bool isq = nt < 19;
            bf16_t* dst = (bf16_t*)(ws + (isq ? WS_QLAT : WS_KVLAT)); const int ld = isq ? QLR : KVLR; const int cb = (isq ? (nt - 16) : (nt - 19)) * 128 + wn * 64 + 8 * hi;
            float* ssq = (float*)(ws + WS_SSQ) + (isq ? 0 : NTOK);
#pragma unroll
            for (int i = 0; i < MI; ++i) {
                const int tok = mt * (64 * MI) + wm * (32 * MI) + 32 * i + r32; float ss = 0.f;
#pragma unroll
                for (int j = 0; j < 2; ++j)
#pragma unroll
                    for (int q = 0; q < 2; ++q) {
                        float v[8];
#pragma unroll
                        for (int e = 0; e < 8; ++e) { v[e] = acc[i][j][8 * q + e]; ss += v[e] * v[e]; }
                        *(u32x4*)(dst + (size_t)tok * ld + cb + 32 * j + 16 * q) = pack8(v);
                    }
                ss = swap32_sum(ss);
                if (hi == 0) atomicAdd(ssq + tok, ss);
            }
        } else if (nt < 25) {
            bf16_t* sz = (bf16_t*)(ws + WS_SZ); const int cb = (nt - 21) * 128 + wn * 64 + 8 * hi;
#pragma unroll
            for (int i = 0; i < MI; ++i) {
                const int tok = mt * (64 * MI) + wm * (32 * MI) + 32 * i + r32;
#pragma unroll
                for (int j = 0; j < 2; ++j)
#pragma unroll
                    for (int q = 0; q < 2; ++q) {
                        float v[8];
#pragma unroll
                        for (int e = 0; e < 8; ++e) v[e] = silu_f(acc[i][j][8 * q + e]);
                        *(u32x4*)(sz + (size_t)tok * AW + cb + 32 * j + 16 * q) = pack8(v);
                    }
            }
        } else if (wn == 0) {
            const float* ct = (const float*)(ws + WS_COS); const float* st = (const float*)(ws + WS_SIN);
            unsigned char* kf = ws + WS_KF;
#pragma unroll
            for (int i = 0; i < MI; ++i) {
                const int tok = mt * (64 * MI) + wm * (32 * MI) + 32 * i + r32; const int pos = tok_pos(tok);
                const f32x4 c0 = *(const f32x4*)(ct + pos * 16 + 8 * hi), c1 = *(const f32x4*)(ct + pos * 16 + 8 * hi + 4);
                const f32x4 s0 = *(const f32x4*)(st + pos * 16 + 8 * hi), s1 = *(const f32x4*)(st + pos * 16 + 8 * hi + 4);
                float o[16];
#pragma unroll
                for (int e = 0; e < 8; ++e) { const float c = e < 4 ? c0[e & 3] : c1[e & 3], s = e < 4 ? s0[e & 3] : s1[e & 3]; const float x1 = acc[i][0][e], x2 = acc[i][0][8 + e]; o[e] = x1 * c - x2 * s; o[8 + e] = x2 * c + x1 * s; }
                const u32x4 w1 = pack16_fp8(o); const int blk = tok >> 5;
#pragma unroll
                for (int h = 0; h < NH; ++h) *(u32x4*)(kf + ((size_t)(h * NBLK32 + blk) * 3 + 2) * 1024 + lane * 16) = w1;
            }
        }
    }
};
struct EpiQ {
    unsigned char* ws;
    template <int MI> __device__ __forceinline__ void operator()(f32x16 (&acc)[MI][3], int mt, int nt, int wm, int wn, int r32, int hi) const {
        const int lane = r32 + 32 * hi, head = nt * 2 + wn;
        const float* ssq = (const float*)(ws + WS_SSQ);
        const float* ct = (const float*)(ws + WS_COS); const float* st = (const float*)(ws + WS_SIN);
#pragma unroll
        for (int i = 0; i < MI; ++i) {
            const int tok = mt * (64 * MI) + wm * (32 * MI) + 32 * i + r32; const int pos = tok_pos(tok);
            const float rs = rsqrtf(__hip_atomic_load(ssq + tok, __ATOMIC_RELAXED, __HIP_MEMORY_SCOPE_AGENT) * (1.f / QLR) + EPS) * C2;
            unsigned char* d = ws + WS_QF + ((size_t)(head * NBLK32 + (tok >> 5)) * 3) * 1024 + lane * 16;
#pragma unroll
            for (int j = 0; j < 2; ++j) {
                float v[16];
#pragma unroll
                for (int r = 0; r < 16; ++r) v[r] = acc[i][j][r] * rs;
                *(u32x4*)(d + j * 1024) = pack16_fp8(v);
            }
            const f32x4 c0 = *(const f32x4*)(ct + pos * 16 + 8 * hi), c1 = *(const f32x4*)(ct + pos * 16 + 8 * hi + 4);
            const f32x4 s0 = *(const f32x4*)(st + pos * 16 + 8 * hi), s1 = *(const f32x4*)(st + pos * 16 + 8 * hi + 4);
            float o[16];
#pragma unroll
            for (int e = 0; e < 8; ++e) { const float c = e < 4 ? c0[e & 3] : c1[e & 3], s = e < 4 ? s0[e & 3] : s1[e & 3]; const float x1 = acc[i][2][e] * rs, x2 = acc[i][2][8 + e] * rs; o[e] = x1 * c - x2 * s; o[8 + e] = x2 * c + x1 * s; }
            *(u32x4*)(d + 2 * 1024) = pack16_fp8(o);
        }
    }
};
struct EpiKV {
    unsigned char* ws;
    template <int MI> __device__ __forceinline__ void operator()(f32x16 (&acc)[MI][2], int mt, int nt, int wm, int wn, int r32, int hi) const {
        static_assert(MI % 2 == 0, "V fragments pair two 32-token blocks");
        const int lane = r32 + 32 * hi, head = nt;
        const float* ssq = (const float*)(ws + WS_SSQ) + NTOK;
        if (wn == 0) {
#pragma unroll
            for (int i = 0; i < MI; ++i) {
                const int tok = mt * (64 * MI) + wm * (32 * MI) + 32 * i + r32;
                const float rs = rsqrtf(__hip_atomic_load(ssq + tok, __ATOMIC_RELAXED, __HIP_MEMORY_SCOPE_AGENT) * (1.f / KVLR) + EPS);
                unsigned char* d = ws + WS_KF + ((size_t)(head * NBLK32 + (tok >> 5)) * 3) * 1024 + lane * 16;
#pragma unroll
                for (int j = 0; j < 2; ++j) {
                    float v[16];
#pragma unroll
                    for (int r = 0; r < 16; ++r) v[r] = acc[i][j][r] * rs;
                    *(u32x4*)(d + j * 1024) = pack16_fp8(v);
                }
            }
        } else {
#pragma unroll
            for (int i = 0; i < MI; ++i) {
                const int tb = mt * (64 * MI) + wm * (32 * MI) + 32 * i;
                float rs[16];
#pragma unroll
                for (int r = 0; r < 16; ++r) rs[r] = rsqrtf(__hip_atomic_load(ssq + tb + crow(r, hi), __ATOMIC_RELAXED, __HIP_MEMORY_SCOPE_AGENT) * (1.f / KVLR) + EPS);
                unsigned char* d = ws + WS_VF + ((size_t)(head * (NTOK / 64) + (tb >> 6)) * 4) * 1024 + (i & 1) * 1024 + lane * 16;
#pragma unroll
                for (int j = 0; j < 2; ++j) {
                    float v[16];
#pragma unroll
                    for (int r = 0; r < 16; ++r) v[r] = acc[i][j][r] * rs[r];
                    *(u32x4*)(d + j * 2048) = pack16_fp8(v);
                }
            }
        }
    }
};
struct EpiOut {
    unsigned char* ws;
    template <int MI> __device__ __forceinline__ void operator()(f32x16 (&acc)[MI][2], int mt, int nt, int wm, int wn, int r32, int hi) const {
        float* ssq = (float*)(ws + WS_SSQ) + 2 * NTOK;
        bf16_t* ob = (bf16_t*)(ws + WS_XN);
#pragma unroll
        for (int i = 0; i < MI; ++i) {
            const int tok = mt * (64 * MI) + wm * (32 * MI) + 32 * i + r32; float ss = 0.f;
            bf16_t* d = ob + (size_t)tok * DM + nt * 128 + wn * 64 + 8 * hi;
#pragma unroll
            for (int j = 0; j < 2; ++j)
#pragma unroll
                for (int q = 0; q < 2; ++q) {
                    float v[8];
#pragma unroll
                    for (int e = 0; e < 8; ++e) { v[e] = acc[i][j][8 * q + e]; ss += v[e] * v[e]; }
                    *(u32x4*)(d + 32 * j + 16 * q) = pack8(v);
                }
            ss = swap32_sum(ss);
            if (hi == 0) atomicAdd(ssq + tok, ss);
        }
    }
};

__device__ __forceinline__ void conv_phase(const Params& p, int gtid, int gthreads) {
    const bf16_t* cu = (const bf16_t*)(p.ws + WS_CU); const bf16_t* gz = (const bf16_t*)(p.ws + WS_GZ); bf16_t* mixa = (bf16_t*)(p.ws + WS_MIXA);
    for (int id = gtid; id < NTOK * 64; id += gthreads) {
        const int tok = id >> 6, c0 = (id & 63) * 8, pos = tok_pos(tok), S = tok < NTOK_P ? SEQ_P : SEQ_S;
        const u32x4 z4 = {0u, 0u, 0u, 0u};
        const u32x4 cm = *(const u32x4*)(cu + (size_t)tok * CW + c0);
        const u32x4 cl = pos > 0 ? *(const u32x4*)(cu + (size_t)(tok - 1) * CW + c0) : z4;
        const u32x4 cr = pos < S - 1 ? *(const u32x4*)(cu + (size_t)(tok + 1) * CW + c0) : z4;
        const u32x4 g = *(const u32x4*)(gz + (size_t)tok * CW + c0);
        float w0[8], w1[8], w2[8], o[8];
#pragma unroll
        for (int e = 0; e < 8; ++e) { w0[e] = p.conv_w[c0 + e]; w1[e] = p.conv_w[CW + c0 + e]; w2[e] = p.conv_w[2 * CW + c0 + e]; }
#pragma unroll
        for (int e = 0; e < 4; ++e) {
            o[2 * e] = bf_lo(g[e]) * (w0[2 * e] * bf_lo(cl[e]) + w1[2 * e] * bf_lo(cm[e]) + w2[2 * e] * bf_lo(cr[e]));
            o[2 * e + 1] = bf_hi(g[e]) * (w0[2 * e + 1] * bf_hi(cl[e]) + w1[2 * e + 1] * bf_hi(cm[e]) + w2[2 * e + 1] * bf_hi(cr[e]));
        }
        *(u32x4*)(mixa + (size_t)tok * CW + c0) = pack8(o);
    }
}

constexpr int AT_STAGE = 40960, AT_NSLOT = 3;
static_assert(AT_NSLOT * AT_STAGE <= LDS_BYTES, "attention ring");
__device__ __forceinline__ float max3f(float a, float b, float c) { float r; asm("v_max3_f32 %0, %1, %2, %3" : "=v"(r) : "v"(a), "v"(b), "v"(c)); return r; }
__device__ __forceinline__ float max2f_pad(float a, float b) { float r; asm("v_max_f32_e32 %0, %1, %2\n\ts_nop 1" : "=v"(r) : "v"(a), "v"(b)); return r; }
#define AT_PIN(x) asm volatile("" : "+v"(x))
__device__ __forceinline__ void attn_dma(unsigned lds0, int slot, srd_t srdK, srd_t srdV, unsigned koff, unsigned voffs, int wid, int lane) {
#pragma unroll
    for (int it = 0; it < 5; ++it) {
        const int pc = wid + 8 * it;
        const unsigned m0v = rflu(lds0 + (unsigned)(slot * AT_STAGE + pc * 1024));
        if (it < 3) bdma16(m0v, (unsigned)lane * 16u, srdK, rflu(koff + (unsigned)pc * 1024u));
        else bdma16(m0v, (unsigned)lane * 16u, srdV, rflu(voffs + (unsigned)(pc - 24) * 1024u));
    }
}
__device__ __forceinline__ void attn_unit(unsigned char* lds, const Params& p, int head, int tok0, int S, int qblk) {
    const int tid = threadIdx.x, lane = tid & 63, wid = __builtin_amdgcn_readfirstlane(tid >> 6), r32 = lane & 31, hi = lane >> 5;
    const unsigned lds0 = rflu((unsigned)(uintptr_t)lds);
    const int tq0 = tok0 + qblk * 256 + wid * 32;
    const srd_t srdK = make_srd(p.ws + WS_KF), srdV = make_srd(p.ws + WS_VF);
    const unsigned koff0 = (unsigned)(head * NBLK32 + (tok0 >> 5)) * 3072u;
    const unsigned voff0 = (unsigned)(head * (NTOK / 64) + (tok0 >> 6)) * 4096u;
    const int NU = S / 256;
    attn_dma(lds0, 0, srdK, srdV, koff0, voff0, wid, lane);
    attn_dma(lds0, 1, srdK, srdV, koff0 + 24576u, voff0 + 16384u, wid, lane);
    u32x4 q0, q1, q2;
    { const unsigned char* qp = p.ws + WS_QF + (size_t)(head * NBLK32 + (tq0 >> 5)) * 3072 + lane * 16;
      q0 = *(const u32x4*)qp; q1 = *(const u32x4*)(qp + 1024); q2 = *(const u32x4*)(qp + 2048); }
    i32x8 Q01 = {(int)q0.x, (int)q0.y, (int)q0.z, (int)q0.w, (int)q1.x, (int)q1.y, (int)q1.z, (int)q1.w};
    i32x8 Q2Z = {(int)q2.x, (int)q2.y, (int)q2.z, (int)q2.w, 0, 0, 0, 0};
    i32x8 ONES = {0x38383838, 0x38383838, 0x38383838, 0x38383838, 0x38383838, 0x38383838, 0x38383838, 0x38383838};
    asm volatile("" : "+v"(Q01), "+v"(Q2Z), "+v"(ONES));
    i32x8 PP = {0, 0, 0, 0, 0, 0, 0, 0};
    f32x16 o0, o1, negm;
#pragma unroll
    for (int r = 0; r < 16; ++r) { o0[r] = 0.f; o1[r] = 0.f; negm[r] = 0.f; }
    AT_PIN(negm);
    float mref = 0.f;
    f32x16 lacc;
#pragma unroll
    for (int r = 0; r < 16; ++r) lacc[r] = 0.f;
    AT_WAIT_BAR(5);
    int slot = 0;
    for (int u = 0; u < NU; ++u) {
        const bool pf = u + 2 < NU;
        const int s2 = slot == 0 ? 2 : slot - 1;
#pragma unroll
        for (int h = 0; h < 4; ++h) {
            if (pf && (wid & 3) == h) attn_dma(lds0, s2, srdK, srdV, koff0 + (unsigned)(u + 2) * 24576u, voff0 + (unsigned)(u + 2) * 16384u, wid, lane);
            const unsigned char* kb = lds + slot * AT_STAGE + h * 6144 + lane * 16;
            const unsigned char* vb = lds + slot * AT_STAGE + 24576 + h * 4096 + lane * 16;
            f32x16 s0, s1;
            { const u32x4 a0 = *(const u32x4*)(kb), a1 = *(const u32x4*)(kb + 1024), a2 = *(const u32x4*)(kb + 2048);
              const u32x4 b0 = *(const u32x4*)(kb + 3072), b1 = *(const u32x4*)(kb + 4096), b2 = *(const u32x4*)(kb + 5120);
              i32x8 KA = {(int)a0.x, (int)a0.y, (int)a0.z, (int)a0.w, (int)a1.x, (int)a1.y, (int)a1.z, (int)a1.w};
              i32x8 KB = {(int)b0.x, (int)b0.y, (int)b0.z, (int)b0.w, (int)b1.x, (int)b1.y, (int)b1.z, (int)b1.w};
              s0 = mfma8v(KA, Q01, negm); s1 = mfma8v(KB, Q01, negm);
              KA[0] = (int)a2.x; KA[1] = (int)a2.y; KA[2] = (int)a2.z; KA[3] = (int)a2.w;
              KB[0] = (int)b2.x; KB[1] = (int)b2.y; KB[2] = (int)b2.z; KB[3] = (int)b2.w;
              s0 = mfma8v(KA, Q2Z, s0);   s1 = mfma8v(KB, Q2Z, s1); }
            asm volatile("s_nop 15\n\ts_nop 15" : "+v"(s0), "+v"(s1));
            float ma = max3f(s0[0], s0[1], s1[0]), mb = max3f(s0[2], s0[3], s1[1]); ma = max3f(ma, s1[2], s1[3]);
#pragma unroll
            for (int r = 4; r < 16; r += 4) { ma = max3f(ma, s0[r], s0[r + 1]); mb = max3f(mb, s0[r + 2], s0[r + 3]); ma = max3f(ma, s1[r], s1[r + 1]); mb = max3f(mb, s1[r + 2], s1[r + 3]); }
            float mx = max2f_pad(ma, mb);
            { auto rr = __builtin_amdgcn_permlane32_swap(__float_as_uint(mx), __float_as_uint(mx), false, false); mx = fmaxf(__uint_as_float(rr[0]), __uint_as_float(rr[1])); }
            const bool first = (u == 0) && (h == 0);
            if (__builtin_expect(first || __any(mx > 7.5f), 0)) {
                const float d = first ? mx - 6.f : fmaxf(mx - 6.f, 0.f);
                mref += d;
                const float f = __builtin_amdgcn_exp2f(-d);
#pragma unroll
                for (int r = 0; r < 16; ++r) { s0[r] -= d; s1[r] -= d; o0[r] *= f; o1[r] *= f; lacc[r] *= f; negm[r] = -mref; }
                AT_PIN(negm);
            }
#pragma unroll
            for (int r = 0; r < 16; ++r) { s0[r] = __builtin_amdgcn_exp2f(s0[r]); s1[r] = __builtin_amdgcn_exp2f(s1[r]); }
            pack32_fp8_into(PP, s0, s1);
            { const u32x4 v00 = *(const u32x4*)(vb), v01 = *(const u32x4*)(vb + 1024), v10 = *(const u32x4*)(vb + 2048), v11 = *(const u32x4*)(vb + 3072);
              const i32x8 V0 = {(int)v00.x, (int)v00.y, (int)v00.z, (int)v00.w, (int)v01.x, (int)v01.y, (int)v01.z, (int)v01.w};
              const i32x8 V1 = {(int)v10.x, (int)v10.y, (int)v10.z, (int)v10.w, (int)v11.x, (int)v11.y, (int)v11.z, (int)v11.w};
              o0 = mfma8v(V0, PP, o0); o1 = mfma8v(V1, PP, o1); lacc = mfma8v(ONES, PP, lacc); }
        }
        if (pf) AT_WAIT_BAR(5); else AT_WAIT_BAR(0);
        slot = slot == 2 ? 0 : slot + 1;
    }
    const float inv = 1.f / lacc[0];
    const int tok = tq0 + r32;
    const bf16_t* sz = (const bf16_t*)(p.ws + WS_SZ) + (size_t)tok * AW + head * 64 + 8 * hi;
    bf16_t* mo = (bf16_t*)(p.ws + WS_MIX2) + (size_t)tok * AW + head * 64 + 8 * hi;
#pragma unroll
    for (int d0 = 0; d0 < 2; ++d0)
#pragma unroll
        for (int q8 = 0; q8 < 2; ++q8) {
            const u32x4 g = *(const u32x4*)(sz + 32 * d0 + 16 * q8);
            float v[8];
#pragma unroll
            for (int e = 0; e < 4; ++e) {
                const float a = d0 == 0 ? o0[8 * q8 + 2 * e] : o1[8 * q8 + 2 * e], b = d0 == 0 ? o0[8 * q8 + 2 * e + 1] : o1[8 * q8 + 2 * e + 1];
                v[2 * e] = a * inv * bf_lo(g[e]); v[2 * e + 1] = b * inv * bf_hi(g[e]);
            }
            *(u32x4*)(mo + 32 * d0 + 16 * q8) = pack8(v);
        }
}


constexpr size_t WS_BAR = 640 * 1024;
#define XB_TMO      128
#define XB_XCNT(j)  (256  + 64 * (j))
#define XB_XSUB(j)  (1280 + 64 * (j))
#define XB_XGEN(j)  (2304 + 64 * (j))
#define XB_TOP      3328
#define XB_TOPGEN   3392
#define XCD_BAR_WORDS 3456
#define XB_SPIN_CAP (1u << 18)
__device__ __forceinline__ unsigned xb_ld(unsigned* p)              { return __hip_atomic_load(p, __ATOMIC_RELAXED, __HIP_MEMORY_SCOPE_AGENT); }
__device__ __forceinline__ unsigned xb_add(unsigned* p, unsigned v) { return __hip_atomic_fetch_add(p, v, __ATOMIC_RELAXED, __HIP_MEMORY_SCOPE_AGENT); }
__device__ __forceinline__ unsigned xb_xcc_id() { return (unsigned)__builtin_amdgcn_s_getreg((3 << 11) | 20) & 0xFu; }
#define XB_SPIN(cond, bar) do { unsigned _sp = 0; while (cond) { __builtin_amdgcn_s_sleep(1); \
    if ((++_sp & 255u) == 0u) { if (xb_ld(&(bar)[XB_TMO])) break; if (_sp > XB_SPIN_CAP) { atomicAdd(&(bar)[XB_TMO], 1u); break; } } } } while (0)
struct XcdBarrier { unsigned* bar; unsigned x; unsigned nloc, nx; };
__device__ __forceinline__ XcdBarrier xcd_barrier_post(unsigned* bar) {
    XcdBarrier b; b.bar = bar; b.x = xb_xcc_id(); b.nloc = 0u; b.nx = 0u;
    if (threadIdx.x == 0) (void)xb_add(&bar[XB_XCNT(b.x)], 1u);
    return b;
}
__device__ __forceinline__ void xcd_barrier_complete(unsigned* bar, unsigned x, unsigned& nloc, unsigned& nx) {
    const unsigned G = gridDim.x * gridDim.y * gridDim.z;
    unsigned sum, cnt, mine, sp = 0u;
    for (;;) {
        sum = 0u; cnt = 0u; mine = 0u;
#pragma unroll
        for (unsigned j = 0; j < 16; ++j) { const unsigned c = xb_ld(&bar[XB_XCNT(j)]); sum += c; cnt += (c > 0u) ? 1u : 0u; mine = (j == x) ? c : mine; }
        if (sum == G) break;
        __builtin_amdgcn_s_sleep(1);
        if ((++sp & 255u) == 0u) { if (xb_ld(&bar[XB_TMO])) break; if (sp > XB_SPIN_CAP) { atomicAdd(&bar[XB_TMO], 1u); break; } }
    }
    nloc = mine > 0u ? mine : 1u; nx = cnt > 0u ? cnt : 1u;
}
__device__ __forceinline__ void xcd_barrier(XcdBarrier& b) {
    asm volatile("s_waitcnt vmcnt(0)" ::: "memory");
    __syncthreads();
    if (threadIdx.x == 0) {
        unsigned* bar = b.bar;
        __builtin_amdgcn_s_waitcnt(0);
        unsigned nloc = b.nloc, nx = b.nx;
        if (nloc == 0u) { xcd_barrier_complete(bar, b.x, nloc, nx); b.nloc = nloc; b.nx = nx; }
        const unsigned old = xb_add(&bar[XB_XSUB(b.x)], 1u);
        const unsigned gen = old / nloc;
        if (old + 1u == (gen + 1u) * nloc) {
            __builtin_amdgcn_fence(__ATOMIC_RELEASE, "agent");
            asm volatile("s_waitcnt vmcnt(0)" ::: "memory");
            const unsigned og = xb_add(&bar[XB_TOP], 1u);
            const unsigned tg = og / nx;
            if (og + 1u == (tg + 1u) * nx) xb_add(&bar[XB_TOPGEN], 1u);
            else XB_SPIN(xb_ld(&bar[XB_TOPGEN]) == tg, bar);
            __builtin_amdgcn_fence(__ATOMIC_ACQUIRE, "agent");
            xb_add(&bar[XB_XGEN(b.x)], 1u);
            asm volatile("s_waitcnt vmcnt(0)" ::: "memory");
        } else {
            XB_SPIN(xb_ld(&bar[XB_XGEN(b.x)]) == gen, bar);
            __builtin_amdgcn_fence(__ATOMIC_ACQUIRE, "agent");
            asm volatile("s_waitcnt vmcnt(0)" ::: "memory");
        }
    }
    __syncthreads();
}

__global__ void __launch_bounds__(NTHR, 2) fwd_kernel(Params p) {
    extern __shared__ __attribute__((aligned(16))) unsigned char lds[];
    cg::grid_group grid = cg::this_grid();
    const int G = gridDim.x, bx = blockIdx.x, tid = threadIdx.x;
    const int gtid = bx * NTHR + tid, gthreads = G * NTHR;
    const int xcd = bx & 7, lb = bx >> 3, GX = G >> 3;
    unsigned char* ws = p.ws;

    __syncthreads();
    XcdBarrier xbar = xcd_barrier_post((unsigned*)(ws + WS_BAR));
    if (p.ws == nullptr) grid.sync();
    phase0(p, gtid, gthreads);
    xcd_barrier(xbar);

    { EpiIn E{ws}; const bf16_t* xn = (const bf16_t*)(ws + WS_XN); const bf16_t* W = (const bf16_t*)(ws + WS_WIN);
      gemm_dma<4, 2, 0>(lds, xn, xn, 1 << 30, DM, W, DM, 13, xcd, lb, GX, E); }
    xcd_barrier(xbar);

    { EpiQ E{ws}; const bf16_t* A = (const bf16_t*)(ws + WS_QLAT); const bf16_t* W = (const bf16_t*)(ws + WS_WUQ);
      gemm_dma<2, 3, 0>(lds, A, A, 1 << 30, QLR, W, QLR, 2, xcd, lb, GX, E); }
    { EpiKV E{ws}; const bf16_t* A = (const bf16_t*)(ws + WS_KVLAT); const bf16_t* W = (const bf16_t*)(ws + WS_WUKV);
      gemm_dma<4, 2, 1>(lds, A, A, 1 << 30, KVLR, W, KVLR, 4, xcd, lb, GX, E); }
    conv_phase(p, gtid, gthreads);
    xcd_barrier(xbar);

    for (int w = lb; w < 128; w += GX) { const int bl = w >> 6, qblk = w & 63; attn_unit(lds, p, xcd, NTOK_P + bl * SEQ_S, SEQ_S, qblk); }
    { unsigned* tick = (unsigned*)(ws + WS_BAR) + 3584 + 64 * xcd;
      for (;;) {
          if (tid == 0) *(volatile unsigned*)lds = xb_add(tick, 1u);
          __syncthreads();
          const unsigned w2 = *(volatile unsigned*)lds;
          __syncthreads();
          if (w2 >= 64u) break;
          attn_unit(lds, p, (int)(w2 >> 3), xcd * SEQ_P, SEQ_P, (int)(w2 & 7));
      } }
    xcd_barrier(xbar);

    { EpiOut E{ws}; const bf16_t* A0 = (const bf16_t*)(ws + WS_MIXA); const bf16_t* A1 = (const bf16_t*)(ws + WS_MIX2); const bf16_t* W = (const bf16_t*)(ws + WS_WOUT);
      gemm_dma<4, 2, 0>(lds, A0, A1, 512, CW, W, DM, 4, xcd, lb, GX, E); }
    xcd_barrier(xbar);

    { const float* ssq = (const float*)(ws + WS_SSQ) + 2 * NTOK; const bf16_t* ob = (const bf16_t*)(ws + WS_XN);
      const int lane = tid & 63, gw = gtid >> 6, nw = gthreads >> 6;
      f32x4 g[4];
#pragma unroll
      for (int j = 0; j < 4; ++j) g[j] = *(const f32x4*)(p.norm_post + 4 * lane + 256 * j);
      for (int row = gw * 2; row < NTOK; row += nw * 2) {
          f32x4 xv[2][4]; u32x2 ov[2][4]; float rs[2];
#pragma unroll
          for (int u = 0; u < 2; ++u) {
              const float* xr = xrow(p, row + u) + 4 * lane; const bf16_t* orow = ob + (size_t)(row + u) * DM + 4 * lane;
#pragma unroll
              for (int j = 0; j < 4; ++j) { xv[u][j] = *(const f32x4*)(xr + 256 * j); ov[u][j] = *(const u32x2*)(orow + 256 * j); }
              rs[u] = rsqrtf(ssq[row + u] * (1.f / DM) + EPS);
          }
#pragma unroll
          for (int u = 0; u < 2; ++u) {
              float* yr = p.out + (size_t)(row + u) * DM + 4 * lane;
#pragma unroll
              for (int j = 0; j < 4; ++j) {
                  f32x4 o; o.x = bf_lo(ov[u][j].x); o.y = bf_hi(ov[u][j].x); o.z = bf_lo(ov[u][j].y); o.w = bf_hi(ov[u][j].y);
                  *(f32x4*)(yr + 256 * j) = xv[u][j] + o * rs[u] * g[j];
              }
          }
      } }
}

extern "C" void kernel_launch(void* const* d_in, const int* in_sizes, int n_in, void* d_out, int out_size, void* d_ws, size_t ws_size, hipStream_t stream) {
    static int grid_blocks = 0;
    if (!grid_blocks) {
        int dev = 0, cus = 0, per_cu = 0;
        hipGetDevice(&dev);
        hipDeviceGetAttribute(&cus, hipDeviceAttributeMultiprocessorCount, dev);
        hipFuncSetAttribute((const void*)fwd_kernel, hipFuncAttributeMaxDynamicSharedMemorySize, LDS_BYTES);
        hipOccupancyMaxActiveBlocksPerMultiprocessor(&per_cu, (const void*)fwd_kernel, NTHR, LDS_BYTES);
        if (per_cu < 1) per_cu = 1;
        if (per_cu > 1) per_cu = 1;
        grid_blocks = cus * per_cu;
        if (ws_size < WS_END) fprintf(stderr, "kernel_launch: workspace too small (%zu < %zu)\n", ws_size, (size_t)WS_END);
    }
    (void)hipMemsetAsync((unsigned char*)d_ws + WS_BAR, 0, 16384, stream);
    Params p{};
    p.x_prompt = (const float*)d_in[0]; p.x_sample = (const float*)d_in[1]; p.norm_pre = (const float*)d_in[2]; p.w_in = (const float*)d_in[3];
    p.conv_w = (const float*)d_in[4]; p.q_norm = (const float*)d_in[5]; p.w_uq = (const float*)d_in[6]; p.kv_norm = (const float*)d_in[7];
    p.w_ukv = (const float*)d_in[8]; p.w_out = (const float*)d_in[9]; p.norm_post = (const float*)d_in[10];
    p.out = (float*)d_out; p.ws = (unsigned char*)d_ws;
    void* args[] = {&p};
    hipError_t e = hipLaunchCooperativeKernel((const void*)fwd_kernel, dim3(grid_blocks), dim3(NTHR), args, LDS_BYTES, stream);
    if (e != hipSuccess) fprintf(stderr, "cooperative launch failed: %s (grid %d)\n", hipGetErrorString(e), grid_blocks);
}
```

```cpp
#include <hip/hip_runtime.h>
#include <hip/hip_cooperative_groups.h>
#include <cstdio>
#include <cstdint>
namespace cg = cooperative_groups;

typedef unsigned short bf16_t;
typedef short bf16x8 __attribute__((ext_vector_type(8)));
typedef float f32x16 __attribute__((ext_vector_type(16)));
typedef float f32x4 __attribute__((ext_vector_type(4)));
typedef float f32x2 __attribute__((ext_vector_type(2)));
typedef unsigned u32x4 __attribute__((ext_vector_type(4)));
typedef unsigned u32x2 __attribute__((ext_vector_type(2)));
#define LAS __attribute__((address_space(3)))

constexpr int DM = 1024, NTOK = 49152, NTOK_P = 16384, SEQ_P = 2048, SEQ_S = 16384;
constexpr int CW = 512, NH = 8, QLR = 384, KVLR = 256, ROPE = 32, AW = 512;
constexpr int NIN = 3328;
constexpr int NBLK32 = NTOK / 32;
constexpr float EPS = 1e-6f;
constexpr float C2 = 0.14724444f;

constexpr size_t MiB = 1u << 20;
constexpr size_t WS_SSQ = 0;
constexpr size_t WS_COS = 1 * MiB, WS_SIN = 2 * MiB;
constexpr size_t WS_WIN = 3 * MiB;
constexpr size_t WS_WUQ = 10 * MiB;
constexpr size_t WS_WUKV = 11 * MiB;
constexpr size_t WS_WOUT = 12 * MiB;
constexpr size_t WS_XN = 16 * MiB;
constexpr size_t WS_QF = 16 * MiB;
constexpr size_t WS_CU = 112 * MiB;
constexpr size_t WS_GZ = 160 * MiB;
constexpr size_t WS_SZ = 208 * MiB;
constexpr size_t WS_QLAT = 256 * MiB;
constexpr size_t WS_KVLAT = 292 * MiB;
constexpr size_t WS_MIX2 = 256 * MiB;
constexpr size_t WS_KF = 316 * MiB;
constexpr size_t WS_VF = 388 * MiB;
constexpr size_t WS_MIXA = 436 * MiB;
constexpr size_t WS_END = 484 * MiB;

constexpr int LDS_BYTES = 131072;
constexpr int NTHR = 512;

struct Params {
    const float* x_prompt; const float* x_sample; const float* norm_pre; const float* w_in; const float* conv_w;
    const float* q_norm; const float* w_uq; const float* kv_norm; const float* w_ukv; const float* w_out; const float* norm_post;
    float* out; unsigned char* ws;
};

__device__ __forceinline__ unsigned pk_bf16(float lo, float hi) {
    typedef __bf16 b2 __attribute__((ext_vector_type(2)));
    f32x2 v = {lo, hi}; b2 b = __builtin_convertvector(v, b2); return __builtin_bit_cast(unsigned, b);
}
__device__ __forceinline__ float bf_lo(unsigned u) { return __uint_as_float(u << 16); }
__device__ __forceinline__ float bf_hi(unsigned u) { return __uint_as_float(u & 0xffff0000u); }
__device__ __forceinline__ u32x4 pack8(const float* v) {
    u32x4 w; w.x = pk_bf16(v[0], v[1]); w.y = pk_bf16(v[2], v[3]); w.z = pk_bf16(v[4], v[5]); w.w = pk_bf16(v[6], v[7]); return w;
}
typedef int i32x8 __attribute__((ext_vector_type(8)));
__device__ __forceinline__ u32x4 pack16_fp8(const float* v) {
    u32x4 w;
#pragma unroll
    for (int k = 0; k < 4; ++k) { int t = __builtin_amdgcn_cvt_pk_fp8_f32(v[4 * k], v[4 * k + 1], 0, false); t = __builtin_amdgcn_cvt_pk_fp8_f32(v[4 * k + 2], v[4 * k + 3], t, true); w[k] = (unsigned)t; }
    return w;
}
__device__ __forceinline__ f32x16 mfma8(u32x4 a0, u32x4 a1, u32x4 b0, u32x4 b1, f32x16 c) {
    const i32x8 A = {(int)a0.x, (int)a0.y, (int)a0.z, (int)a0.w, (int)a1.x, (int)a1.y, (int)a1.z, (int)a1.w};
    const i32x8 B = {(int)b0.x, (int)b0.y, (int)b0.z, (int)b0.w, (int)b1.x, (int)b1.y, (int)b1.z, (int)b1.w};
    return __builtin_amdgcn_mfma_scale_f32_32x32x64_f8f6f4(A, B, c, 0, 0, 0, 0x7f7f7f7f, 0, 0x7f7f7f7f);
}
__device__ __forceinline__ f32x16 mfma8v(i32x8 A, i32x8 B, f32x16 c) { return __builtin_amdgcn_mfma_scale_f32_32x32x64_f8f6f4(A, B, c, 0, 0, 0, 0x7f7f7f7f, 0, 0x7f7f7f7f); }
__device__ __forceinline__ void pack32_fp8_into(i32x8& P, const f32x16& s0, const f32x16& s1) {
#pragma unroll
    for (int k = 0; k < 4; ++k) { int t = __builtin_amdgcn_cvt_pk_fp8_f32(s0[4 * k], s0[4 * k + 1], P[k], false); P[k] = __builtin_amdgcn_cvt_pk_fp8_f32(s0[4 * k + 2], s0[4 * k + 3], t, true); }
#pragma unroll
    for (int k = 0; k < 4; ++k) { int t = __builtin_amdgcn_cvt_pk_fp8_f32(s1[4 * k], s1[4 * k + 1], P[4 + k], false); P[4 + k] = __builtin_amdgcn_cvt_pk_fp8_f32(s1[4 * k + 2], s1[4 * k + 3], t, true); }
}
__device__ __forceinline__ float silu_f(float z) { return z / (1.f + __expf(-z)); }
__device__ __forceinline__ int cperm(int p) { const int hp = (p >> 2) & 1, r = (p & 3) + 4 * (p >> 3); return 16 * (r >> 3) + 8 * hp + (r & 7); }
__device__ __forceinline__ int crow(int r, int hi) { return (r & 3) + 8 * (r >> 2) + 4 * hi; }
__device__ __forceinline__ float swap32_max(float m) {
    auto rr = __builtin_amdgcn_permlane32_swap(__float_as_uint(m), __float_as_uint(m), false, false);
    return fmaxf(__uint_as_float(rr[0]), __uint_as_float(rr[1]));
}
__device__ __forceinline__ float swap32_sum(float m) {
    auto rr = __builtin_amdgcn_permlane32_swap(__float_as_uint(m), __float_as_uint(m), false, false);
    return __uint_as_float(rr[0]) + __uint_as_float(rr[1]);
}
__device__ __forceinline__ float wave_sum(float v) {
#pragma unroll
    for (int o = 1; o < 64; o <<= 1) v += __shfl_xor(v, o);
    return v;
}
__device__ __forceinline__ const float* xrow(const Params& p, int tok) {
    return tok < NTOK_P ? p.x_prompt + (size_t)tok * DM : p.x_sample + (size_t)(tok - NTOK_P) * DM;
}
__device__ __forceinline__ int tok_pos(int tok) { return tok < NTOK_P ? (tok & (SEQ_P - 1)) : (tok & (SEQ_S - 1)); }

__device__ __forceinline__ void glds16(const void* gsrc, unsigned lds_dst) {
    unsigned keep;
    asm volatile("s_mov_b32 %0, m0\n\ts_mov_b32 m0, %2\n\ts_nop 0\n\tglobal_load_lds_dwordx4 %1, off\n\ts_mov_b32 m0, %0" : "=&s"(keep) : "v"(gsrc), "s"(lds_dst) : "memory");
}
#define AT_WAIT_BAR(N) asm volatile("s_waitcnt vmcnt(" #N ") lgkmcnt(0)\n\ts_barrier" ::: "memory")
typedef __amdgpu_buffer_rsrc_t srd_t;
__device__ __forceinline__ srd_t make_srd(const void* base) { return __builtin_amdgcn_make_buffer_rsrc((void*)base, (short)0, 0x7ffffffe, 0x00020000); }
__device__ __forceinline__ void bdma16(unsigned m0v, unsigned voff, srd_t srd, unsigned soff) {
    asm volatile("s_nop 4\n\ts_mov_b32 m0, %0\n\ts_nop 0\n\tbuffer_load_dwordx4 %1, %2, %3 offen lds" :: "s"(m0v), "v"(voff), "s"(srd), "s"(soff) : "m0", "memory");
}
__device__ __forceinline__ unsigned rflu(unsigned v) { return (unsigned)__builtin_amdgcn_readfirstlane((int)v); }

__device__ __forceinline__ int win_src(int np) {
    const int T = np >> 7, w = np & 127;
    if (T < 16) { const int wn = w >> 6, j = (w >> 5) & 1, q = (w >> 4) & 1, i16 = w & 15; return (2 * j + q) * 512 + 32 * T + 16 * wn + i16; }
    if (T < 21) return np;
    if (T < 25) return 2720 + (np - 2688);
    return w < 32 ? 2688 + w : -1;
}
template <int MODE>
__device__ __forceinline__ void prep_weight(const float* __restrict__ w, const float* __restrict__ gain, bf16_t* WT, int K, int Nsrc, int Ndst, int gtid, int gthreads) {
    const int items = Ndst * (K / 8);
    for (int id = gtid; id < items; id += gthreads) {
        const int n = id % Ndst, kc = id / Ndst, k0 = kc * 8;
        const int src = (MODE == 1) ? win_src(n) : n;
        float v[8];
#pragma unroll
        for (int e = 0; e < 8; ++e) v[e] = (src >= 0) ? w[(size_t)(k0 + e) * Nsrc + src] * (gain ? gain[k0 + e] : 1.f) : 0.f;
        *(u32x4*)(WT + (size_t)n * K + k0) = pack8(v);
    }
}
__device__ __forceinline__ void rope_entry(int pos, int i, float& c, float& s) {
    const int a = i & 3, b = i >> 2;
    double base = a == 0 ? 1.0 : a == 1 ? 0.5623413251903491 : a == 2 ? 0.31622776601683794 : 0.1778279410038923;
    double sc = b == 0 ? 1.0 : b == 1 ? 0.1 : b == 2 ? 0.01 : 0.001;
    const float freq = (float)(base * sc);
    const float angf = (float)pos * freq;
    const double x = (double)angf;
    const double kq = rint(x * 0.6366197723675814);
    const double r = (x - kq * 1.5707963267948966) - kq * 6.123233995736766e-17;
    const double r2 = r * r;
    const double sn = r * (1.0 + r2 * (-1.0 / 6 + r2 * (1.0 / 120 + r2 * (-1.0 / 5040 + r2 * (1.0 / 362880 + r2 * (-1.0 / 39916800))))));
    const double cs = 1.0 + r2 * (-0.5 + r2 * (1.0 / 24 + r2 * (-1.0 / 720 + r2 * (1.0 / 40320 + r2 * (-1.0 / 3628800 + r2 * (1.0 / 479001600))))));
    const int qd = ((int)kq) & 3;
    const double so = qd == 0 ? sn : qd == 1 ? cs : qd == 2 ? -sn : -cs;
    const double co = qd == 0 ? cs : qd == 1 ? -sn : qd == 2 ? -cs : sn;
    c = (float)co; s = (float)so;
}
__device__ __forceinline__ void phase0(const Params& p, int gtid, int gthreads) {
    unsigned char* ws = p.ws;
    float* ssq = (float*)(ws + WS_SSQ);
    for (int i = gtid; i < 3 * NTOK; i += gthreads) ssq[i] = 0.f;
    float* ct = (float*)(ws + WS_COS); float* st = (float*)(ws + WS_SIN);
    for (int i = gtid; i < SEQ_S * 16; i += gthreads) { float c, s; rope_entry(i >> 4, i & 15, c, s); ct[i] = c; st[i] = s; }
    prep_weight<1>(p.w_in, p.norm_pre, (bf16_t*)(ws + WS_WIN), DM, 3232, NIN, gtid, gthreads);
    prep_weight<0>(p.w_uq, p.q_norm, (bf16_t*)(ws + WS_WUQ), QLR, 768, 768, gtid, gthreads);
    prep_weight<0>(p.w_ukv, p.kv_norm, (bf16_t*)(ws + WS_WUKV), KVLR, 1024, 1024, gtid, gthreads);
    prep_weight<0>(p.w_out, nullptr, (bf16_t*)(ws + WS_WOUT), DM, 1024, 1024, gtid, gthreads);
    const int gw = gtid >> 6, nw = gthreads >> 6, lane = threadIdx.x & 63;
    bf16_t* xn = (bf16_t*)(ws + WS_XN);
    for (int row = gw * 2; row < NTOK; row += nw * 2) {
        f32x4 v[2][4]; float s[2];
#pragma unroll
        for (int u = 0; u < 2; ++u) {
            const f32x4* xr = (const f32x4*)xrow(p, row + u) + lane; s[u] = 0.f;
#pragma unroll
            for (int j = 0; j < 4; ++j) { v[u][j] = __builtin_nontemporal_load(xr + 64 * j); }
        }
#pragma unroll
        for (int u = 0; u < 2; ++u) {
#pragma unroll
            for (int j = 0; j < 4; ++j) s[u] += (v[u][j].x * v[u][j].x + v[u][j].y * v[u][j].y) + (v[u][j].z * v[u][j].z + v[u][j].w * v[u][j].w);
            const float rs = rsqrtf(wave_sum(s[u]) * (1.f / DM) + EPS);
            u32x2* o = (u32x2*)(xn + (size_t)(row + u) * DM) + lane;
#pragma unroll
            for (int j = 0; j < 4; ++j) { u32x2 w; w.x = pk_bf16(v[u][j].x * rs, v[u][j].y * rs); w.y = pk_bf16(v[u][j].z * rs, v[u][j].w * rs); o[64 * j] = w; }
        }
    }
}

__device__ __forceinline__ void tile_map(int w, int NT, int xcd, int MPX, int& mt, int& nt) {
    const int g = w / (8 * NT), rem = w % (8 * NT);
    nt = rem >> 3; mt = xcd * MPX + g * 8 + (rem & 7);
}
template <int MI, int NJ, int MODE, class Epi>
__device__ __forceinline__ void gemm_dma(unsigned char* lds, const bf16_t* __restrict__ A0, const bf16_t* __restrict__ A1, int ksplit, int lda,
                                         const bf16_t* __restrict__ Bt, int K, int NT, int xcd, int lb, int GX, const Epi& epi) {
    constexpr int NSA = 4 * MI, NSUB = 4 * MI + 8 * NJ, STAGE = NSUB * 1024, NIT = NSUB / 8, NITA = NSA / 8, BOFF = NSA * 1024, MPX = 96 / MI;
    static_assert(4 * STAGE <= LDS_BYTES && NSUB % 8 == 0 && NSA % 8 == 0, "lds");
    const int tid = threadIdx.x, lane = tid & 63, wid = __builtin_amdgcn_readfirstlane(tid >> 6), wm = wid >> 2, wn = wid & 3;
    const int r32 = lane & 31, hi = lane >> 5;
    const unsigned lds0 = rflu((unsigned)(uintptr_t)lds);
    const int nk = K / 32, count = MPX * NT;
    int w = lb;
    if (w >= count) return;
    int mt, nt; tile_map(w, NT, xcd, MPX, mt, nt);
    const int rowl = lane >> 2, colsw = 8 * ((lane & 3) ^ ((lane >> 4) & 3));
    const unsigned voffA = (unsigned)((rowl * lda + colsw) * 2), voffB = (unsigned)((rowl * K + colsw) * 2);
    const srd_t srdA0 = make_srd(A0), srdA1 = make_srd(A1), srdB = make_srd(Bt);
    auto dma = [&](int tmt, int tnt, int kt, int stage) {
        const int k0 = kt * 32;
        const bool lo = k0 < ksplit;
        const unsigned sa = (unsigned)(tmt * 64 * MI) * (unsigned)(lda * 2) + (unsigned)((lo ? k0 : k0 - ksplit) * 2);
        const unsigned sbb = (unsigned)(tnt * 128 * NJ) * (unsigned)(K * 2) + (unsigned)(k0 * 2);
#pragma unroll
        for (int it = 0; it < NIT; ++it) {
            const int f = wid + 8 * it;
            const unsigned m0v = rflu(lds0 + (unsigned)(stage * STAGE + f * 1024));
            if (it < NITA) { const unsigned so = rflu(sa + (unsigned)(f * 16) * (unsigned)(lda * 2)); if (lo) bdma16(m0v, voffA, srdA0, so); else bdma16(m0v, voffA, srdA1, so); }
            else { const unsigned so = rflu(sbb + (unsigned)((f - NSA) * 16) * (unsigned)(K * 2)); bdma16(m0v, voffB, srdB, so); }
        }
    };
    const int cb = cperm(r32);
    const int arow = (wm * 32 * MI + r32), brow = (wn * 32 * NJ + cb);
    const int abase = (arow >> 4) * 1024 + (arow & 15) * 64, ax = (arow >> 2) & 3;
    const int bbase = BOFF + (brow >> 4) * 1024 + (brow & 15) * 64, bx_ = (brow >> 2) & 3;
    const bool swp = (MODE == 0) || ((wn & 1) == 0);
    f32x16 acc[MI][NJ];
    auto compute = [&](int stage) {
        const unsigned char* base = lds + stage * STAGE;
#pragma unroll
        for (int kk = 0; kk < 2; ++kk) {
            bf16x8 af[MI], bfr[NJ];
            const int ca = ((2 * kk + hi) ^ ax) << 4, cbb = ((2 * kk + hi) ^ bx_) << 4;
#pragma unroll
            for (int i = 0; i < MI; ++i) af[i] = *(const bf16x8*)(base + abase + i * 2048 + ca);
#pragma unroll
            for (int j = 0; j < NJ; ++j) bfr[j] = *(const bf16x8*)(base + bbase + j * 2048 + cbb);
#pragma unroll
            for (int i = 0; i < MI; ++i)
#pragma unroll
                for (int j = 0; j < NJ; ++j) {
                    if (MODE == 0) acc[i][j] = __builtin_amdgcn_mfma_f32_32x32x16_bf16(bfr[j], af[i], acc[i][j], 0, 0, 0);
                    else { const bf16x8 xa = swp ? bfr[j] : af[i], xb = swp ? af[i] : bfr[j]; acc[i][j] = __builtin_amdgcn_mfma_f32_32x32x16_bf16(xa, xb, acc[i][j], 0, 0, 0); }
                }
        }
    };
    auto dma2 = [&](int tmt, int tnt, int kt2, int sb) { dma(tmt, tnt, 2 * kt2, 2 * sb); dma(tmt, tnt, 2 * kt2 + 1, 2 * sb + 1); };
    dma2(mt, nt, 0, 0);
    int sb = 0;
    const int nk2 = nk >> 1;
    for (;;) {
        const int wnx = w + GX; const bool has_next = wnx < count;
        int mt2 = mt, nt2 = nt; if (has_next) tile_map(wnx, NT, xcd, MPX, mt2, nt2);
#pragma unroll
        for (int i = 0; i < MI; ++i)
#pragma unroll
            for (int j = 0; j < NJ; ++j)
#pragma unroll
                for (int r = 0; r < 16; ++r) acc[i][j][r] = 0.f;
        AT_WAIT_BAR(0);
        for (int kt2 = 0; kt2 < nk2; ++kt2) {
            const bool last = kt2 + 1 == nk2;
            if (wm == 0) { if (!last) dma2(mt, nt, kt2 + 1, sb ^ 1); else if (has_next) dma2(mt2, nt2, 0, sb ^ 1); }
            compute(2 * sb);
            if (wm != 0) { if (!last) dma2(mt, nt, kt2 + 1, sb ^ 1); else if (has_next) dma2(mt2, nt2, 0, sb ^ 1); }
            compute(2 * sb + 1);
            if (!last) AT_WAIT_BAR(0);
            sb ^= 1;
        }
        epi(acc, mt, nt * 2 + (wn >> 1), wm, wn & 1, r32, hi);
        if (!has_next) break;
        w = wnx; mt = mt2; nt = nt2;
    }
    AT_WAIT_BAR(0);
}

struct EpiIn {
    unsigned char* ws;
    template <int MI> __device__ __forceinline__ void operator()(f32x16 (&acc)[MI][2], int mt, int nt, int wm, int wn, int r32, int hi) const {
        const int lane = r32 + 32 * hi;
        if (nt < 16) {
            bf16_t* cu = (bf16_t*)(ws + WS_CU); bf16_t* gz = (bf16_t*)(ws + WS_GZ);
#pragma unroll
            for (int i = 0; i < MI; ++i) {
                const int tok = mt * (64 * MI) + wm * (32 * MI) + 32 * i + r32; const int ch0 = 32 * nt + 16 * wn + 8 * hi;
                float a[8], b[8];
#pragma unroll
                for (int e = 0; e < 8; ++e) { const float u = acc[i][0][e], B = acc[i][0][8 + e], C = acc[i][1][e], z = acc[i][1][8 + e]; a[e] = C * u; b[e] = B * silu_f(z); }
                *(u32x4*)(cu + (size_t)tok * CW + ch0) = pack8(a);
                *(u32x4*)(gz + (size_t)tok * CW + ch0) = pack8(b);
            }
        } else if (nt < 21) {
            const bool isq = nt < 19;
            bf16_t* dst = (bf16_t*)(ws + (isq ? WS_QLAT : WS_KVLAT)); const int ld = isq ? QLR : KVLR; const int cb = (isq ? (nt - 16) : (nt - 19)) * 128 + wn * 64 + 8 * hi;
            float* ssq = (float*)(ws + WS_SSQ) + (isq ? 0 : NTOK);
#pragma unroll
            for (int i = 0; i < MI; ++i) {
                const int tok = mt * (64 * MI) + wm * (32 * MI) + 32 * i + r32; float ss = 0.f;
#pragma unroll
                for (int j = 0; j < 2; ++j)
#pragma unroll
                    for (int q = 0; q < 2; ++q) {
                        float v[8];
#pragma unroll
                        for (int e = 0; e < 8; ++e) { v[e] = acc[i][j][8 * q + e]; ss += v[e] * v[e]; }
                        *(u32x4*)(dst + (size_t)tok * ld + cb + 32 * j + 16 * q) = pack8(v);
                    }
                ss = swap32_sum(ss);
                if (hi == 0) atomicAdd(ssq + tok, ss);
            }
        } else if (nt < 25) {
            bf16_t* sz = (bf16_t*)(ws + WS_SZ); const int cb = (nt - 21) * 128 + wn * 64 + 8 * hi;
#pragma unroll
            for (int i = 0; i < MI; ++i) {
                const int tok = mt * (64 * MI) + wm * (32 * MI) + 32 * i + r32;
#pragma unroll
                for (int j = 0; j < 2; ++j)
#pragma unroll
                    for (int q = 0; q < 2; ++q) {
                        float v[8];
#pragma unroll
                        for (int e = 0; e < 8; ++e) v[e] = silu_f(acc[i][j][8 * q + e]);
                        *(u32x4*)(sz + (size_t)tok * AW + cb + 32 * j + 16 * q) = pack8(v);
                    }
            }
        } else if (wn == 0) {
            const float* ct = (const float*)(ws + WS_COS); const float* st = (const float*)(ws + WS_SIN);
            unsigned char* kf = ws + WS_KF;
#pragma unroll
            for (int i = 0; i < MI; ++i) {
                const int tok = mt * (64 * MI) + wm * (32 * MI) + 32 * i + r32; const int pos = tok_pos(tok);
                const f32x4 c0 = *(const f32x4*)(ct + pos * 16 + 8 * hi), c1 = *(const f32x4*)(ct + pos * 16 + 8 * hi + 4);
                const f32x4 s0 = *(const f32x4*)(st + pos * 16 + 8 * hi), s1 = *(const f32x4*)(st + pos * 16 + 8 * hi + 4);
                float o[16];
#pragma unroll
                for (int e = 0; e < 8; ++e) { const float c = e < 4 ? c0[e & 3] : c1[e & 3], s = e < 4 ? s0[e & 3] : s1[e & 3]; const float x1 = acc[i][0][e], x2 = acc[i][0][8 + e]; o[e] = x1 * c - x2 * s; o[8 + e] = x2 * c + x1 * s; }
                const u32x4 w1 = pack16_fp8(o); const int blk = tok >> 5;
#pragma unroll
                for (int h = 0; h < NH; ++h) *(u32x4*)(kf + ((size_t)(h * NBLK32 + blk) * 3 + 2) * 1024 + lane * 16) = w1;
            }
        }
    }
};
struct EpiQ {
    unsigned char* ws;
    template <int MI> __device__ __forceinline__ void operator()(f32x16 (&acc)[MI][3], int mt, int nt, int wm, int wn, int r32, int hi) const {
        const int lane = r32 + 32 * hi, head = nt * 2 + wn;
        const float* ssq = (const float*)(ws + WS_SSQ);
        const float* ct = (const float*)(ws + WS_COS); const float* st = (const float*)(ws + WS_SIN);
#pragma unroll
        for (int i = 0; i < MI; ++i) {
            const int tok = mt * (64 * MI) + wm * (32 * MI) + 32 * i + r32; const int pos = tok_pos(tok);
            const float rs = rsqrtf(__hip_atomic_load(ssq + tok, __ATOMIC_RELAXED, __HIP_MEMORY_SCOPE_AGENT) * (1.f / QLR) + EPS) * C2;
            unsigned char* d = ws + WS_QF + ((size_t)(head * NBLK32 + (tok >> 5)) * 3) * 1024 + lane * 16;
#pragma unroll
            for (int j = 0; j < 2; ++j) {
                float v[16];
#pragma unroll
                for (int r = 0; r < 16; ++r) v[r] = acc[i][j][r] * rs;
                *(u32x4*)(d + j * 1024) = pack16_fp8(v);
            }
            const f32x4 c0 = *(const f32x4*)(ct + pos * 16 + 8 * hi), c1 = *(const f32x4*)(ct + pos * 16 + 8 * hi + 4);
            const f32x4 s0 = *(const f32x4*)(st + pos * 16 + 8 * hi), s1 = *(const f32x4*)(st + pos * 16 + 8 * hi + 4);
            float o[16];
#pragma unroll
            for (int e = 0; e < 8; ++e) { const float c = e < 4 ? c0[e & 3] : c1[e & 3], s = e < 4 ? s0[e & 3] : s1[e & 3]; const float x1 = acc[i][2][e] * rs, x2 = acc[i][2][8 + e] * rs; o[e] = x1 * c - x2 * s; o[8 + e] = x2 * c + x1 * s; }
            *(u32x4*)(d + 2 * 1024) = pack16_fp8(o);
        }
    }
};
struct EpiKV {
    unsigned char* ws;
    template <int MI> __device__ __forceinline__ void operator()(f32x16 (&acc)[MI][2], int mt, int nt, int wm, int wn, int r32, int hi) const {
        static_assert(MI % 2 == 0, "V fragments pair two 32-token blocks");
        const int lane = r32 + 32 * hi, head = nt;
        const float* ssq = (const float*)(ws + WS_SSQ) + NTOK;
        if (wn == 0) {
#pragma unroll
            for (int i = 0; i < MI; ++i) {
                const int tok = mt * (64 * MI) + wm * (32 * MI) + 32 * i + r32;
                const float rs = rsqrtf(__hip_atomic_load(ssq + tok, __ATOMIC_RELAXED, __HIP_MEMORY_SCOPE_AGENT) * (1.f / KVLR) + EPS);
                unsigned char* d = ws + WS_KF + ((size_t)(head * NBLK32 + (tok >> 5)) * 3) * 1024 + lane * 16;
#pragma unroll
                for (int j = 0; j < 2; ++j) {
                    float v[16];
#pragma unroll
                    for (int r = 0; r < 16; ++r) v[r] = acc[i][j][r] * rs;
                    *(u32x4*)(d + j * 1024) = pack16_fp8(v);
                }
            }
        } else {
#pragma unroll
            for (int i = 0; i < MI; ++i) {
                const int tb = mt * (64 * MI) + wm * (32 * MI) + 32 * i;
                float rs[16];
#pragma unroll
                for (int r = 0; r < 16; ++r) rs[r] = rsqrtf(__hip_atomic_load(ssq + tb + crow(r, hi), __ATOMIC_RELAXED, __HIP_MEMORY_SCOPE_AGENT) * (1.f / KVLR) + EPS);
                unsigned char* d = ws + WS_VF + ((size_t)(head * (NTOK / 64) + (tb >> 6)) * 4) * 1024 + (i & 1) * 1024 + lane * 16;
#pragma unroll
                for (int j = 0; j < 2; ++j) {
                    float v[16];
#pragma unroll
                    for (int r = 0; r < 16; ++r) v[r] = acc[i][j][r] * rs[r];
                    *(u32x4*)(d + j * 2048) = pack16_fp8(v);
                }
            }
        }
    }
};
struct EpiOut {
    unsigned char* ws;
    template <int MI> __device__ __forceinline__ void operator()(f32x16 (&acc)[MI][2], int mt, int nt, int wm, int wn, int r32, int hi) const {
        float* ssq = (float*)(ws + WS_SSQ) + 2 * NTOK;
        bf16_t* ob = (bf16_t*)(ws + WS_XN);
#pragma unroll
        for (int i = 0; i < MI; ++i) {
            const int tok = mt * (64 * MI) + wm * (32 * MI) + 32 * i + r32; float ss = 0.f;
            bf16_t* d = ob + (size_t)tok * DM + nt * 128 + wn * 64 + 8 * hi;
#pragma unroll
            for (int j = 0; j < 2; ++j)
#pragma unroll
                for (int q = 0; q < 2; ++q) {
                    float v[8];
#pragma unroll
                    for (int e = 0; e < 8; ++e) { v[e] = acc[i][j][8 * q + e]; ss += v[e] * v[e]; }
                    *(u32x4*)(d + 32 * j + 16 * q) = pack8(v);
                }
            ss = swap32_sum(ss);
            if (hi == 0) atomicAdd(ssq + tok, ss);
        }
    }
};

__device__ __forceinline__ void conv_phase(const Params& p, int gtid, int gthreads) {
    const bf16_t* cu = (const bf16_t*)(p.ws + WS_CU); const bf16_t* gz = (const bf16_t*)(p.ws + WS_GZ); bf16_t* mixa = (bf16_t*)(p.ws + WS_MIXA);
    for (int id = gtid; id < NTOK * 64; id += gthreads) {
        const int tok = id >> 6, c0 = (id & 63) * 8, pos = tok_pos(tok), S = tok < NTOK_P ? SEQ_P : SEQ_S;
        const u32x4 z4 = {0u, 0u, 0u, 0u};
        const u32x4 cm = *(const u32x4*)(cu + (size_t)tok * CW + c0);
        const u32x4 cl = pos > 0 ? *(const u32x4*)(cu + (size_t)(tok - 1) * CW + c0) : z4;
        const u32x4 cr = pos < S - 1 ? *(const u32x4*)(cu + (size_t)(tok + 1) * CW + c0) : z4;
        const u32x4 g = *(const u32x4*)(gz + (size_t)tok * CW + c0);
        float w0[8], w1[8], w2[8], o[8];
#pragma unroll
        for (int e = 0; e < 8; ++e) { w0[e] = p.conv_w[c0 + e]; w1[e] = p.conv_w[CW + c0 + e]; w2[e] = p.conv_w[2 * CW + c0 + e]; }
#pragma unroll
        for (int e = 0; e < 4; ++e) {
            o[2 * e] = bf_lo(g[e]) * (w0[2 * e] * bf_lo(cl[e]) + w1[2 * e] * bf_lo(cm[e]) + w2[2 * e] * bf_lo(cr[e]));
            o[2 * e + 1] = bf_hi(g[e]) * (w0[2 * e + 1] * bf_hi(cl[e]) + w1[2 * e + 1] * bf_hi(cm[e]) + w2[2 * e + 1] * bf_hi(cr[e]));
        }
        *(u32x4*)(mixa + (size_t)tok * CW + c0) = pack8(o);
    }
}

constexpr int AT_STAGE = 40960, AT_NSLOT = 3;
static_assert(AT_NSLOT * AT_STAGE <= LDS_BYTES, "attention ring");
__device__ __forceinline__ float max3f(float a, float b, float c) { float r; asm("v_max3_f32 %0, %1, %2, %3" : "=v"(r) : "v"(a), "v"(b), "v"(c)); return r; }
__device__ __forceinline__ float max2f_pad(float a, float b) { float r; asm("v_max_f32_e32 %0, %1, %2\n\ts_nop 1" : "=v"(r) : "v"(a), "v"(b)); return r; }
#define AT_PIN(x) asm volatile("" : "+v"(x))
__device__ __forceinline__ void attn_dma(unsigned lds0, int slot, srd_t srdK, srd_t srdV, unsigned koff, unsigned voffs, int wid, int lane) {
#pragma unroll
    for (int it = 0; it < 5; ++it) {
        const int pc = wid + 8 * it;
        const unsigned m0v = rflu(lds0 + (unsigned)(slot * AT_STAGE + pc * 1024));
        if (it < 3) bdma16(m0v, (unsigned)lane * 16u, srdK, rflu(koff + (unsigned)pc * 1024u));
        else bdma16(m0v, (unsigned)lane * 16u, srdV, rflu(voffs + (unsigned)(pc - 24) * 1024u));
    }
}
__device__ __forceinline__ void attn_unit(unsigned char* lds, const Params& p, int head, int tok0, int S, int qblk) {
    const int tid = threadIdx.x, lane = tid & 63, wid = __builtin_amdgcn_readfirstlane(tid >> 6), r32 = lane & 31, hi = lane >> 5;
    const unsigned lds0 = rflu((unsigned)(uintptr_t)lds);
    const int tq0 = tok0 + qblk * 256 + wid * 32;
    const srd_t srdK = make_srd(p.ws + WS_KF), srdV = make_srd(p.ws + WS_VF);
    const unsigned koff0 = (unsigned)(head * NBLK32 + (tok0 >> 5)) * 3072u;
    const unsigned voff0 = (unsigned)(head * (NTOK / 64) + (tok0 >> 6)) * 4096u;
    const int NU = S / 256;
    attn_dma(lds0, 0, srdK, srdV, koff0, voff0, wid, lane);
    attn_dma(lds0, 1, srdK, srdV, koff0 + 24576u, voff0 + 16384u, wid, lane);
    u32x4 q0, q1, q2;
    { const unsigned char* qp = p.ws + WS_QF + (size_t)(head * NBLK32 + (tq0 >> 5)) * 3072 + lane * 16;
      q0 = *(const u32x4*)qp; q1 = *(const u32x4*)(qp + 1024); q2 = *(const u32x4*)(qp + 2048); }
    i32x8 Q01 = {(int)q0.x, (int)q0.y, (int)q0.z, (int)q0.w, (int)q1.x, (int)q1.y, (int)q1.z, (int)q1.w};
    i32x8 Q2Z = {(int)q2.x, (int)q2.y, (int)q2.z, (int)q2.w, 0, 0, 0, 0};
    i32x8 ONES = {0x38383838, 0x38383838, 0x38383838, 0x38383838, 0x38383838, 0x38383838, 0x38383838, 0x38383838};
    asm volatile("" : "+v"(Q01), "+v"(Q2Z), "+v"(ONES));
    i32x8 PP = {0, 0, 0, 0, 0, 0, 0, 0};
    f32x16 o0, o1, negm;
#pragma unroll
    for (int r = 0; r < 16; ++r) { o0[r] = 0.f; o1[r] = 0.f; negm[r] = 0.f; }
    AT_PIN(negm);
    float mref = 0.f;
    f32x16 lacc;
#pragma unroll
    for (int r = 0; r < 16; ++r) lacc[r] = 0.f;
    AT_WAIT_BAR(5);
    int slot = 0;
    for (int u = 0; u < NU; ++u) {
        const bool pf = u + 2 < NU;
        const int s2 = slot == 0 ? 2 : slot - 1;
#pragma unroll
        for (int h = 0; h < 4; ++h) {
            if (pf && (wid & 3) == h) attn_dma(lds0, s2, srdK, srdV, koff0 + (unsigned)(u + 2) * 24576u, voff0 + (unsigned)(u + 2) * 16384u, wid, lane);
            const unsigned char* kb = lds + slot * AT_STAGE + h * 6144 + lane * 16;
            const unsigned char* vb = lds + slot * AT_STAGE + 24576 + h * 4096 + lane * 16;
            f32x16 s0, s1;
            { const u32x4 a0 = *(const u32x4*)(kb), a1 = *(const u32x4*)(kb + 1024), a2 = *(const u32x4*)(kb + 2048);
              const u32x4 b0 = *(const u32x4*)(kb + 3072), b1 = *(const u32x4*)(kb + 4096), b2 = *(const u32x4*)(kb + 5120);
              i32x8 KA = {(int)a0.x, (int)a0.y, (int)a0.z, (int)a0.w, (int)a1.x, (int)a1.y, (int)a1.z, (int)a1.w};
              i32x8 KB = {(int)b0.x, (int)b0.y, (int)b0.z, (int)b0.w, (int)b1.x, (int)b1.y, (int)b1.z, (int)b1.w};
              s0 = mfma8v(KA, Q01, negm); s1 = mfma8v(KB, Q01, negm);
              KA[0] = (int)a2.x; KA[1] = (int)a2.y; KA[2] = (int)a2.z; KA[3] = (int)a2.w;
              KB[0] = (int)b2.x; KB[1] = (int)b2.y; KB[2] = (int)b2.z; KB[3] = (int)b2.w;
              s0 = mfma8v(KA, Q2Z, s0);   s1 = mfma8v(KB, Q2Z, s1); }
            asm volatile("s_nop 15\n\ts_nop 15" : "+v"(s0), "+v"(s1));
            float ma = max3f(s0[0], s0[1], s1[0]), mb = max3f(s0[2], s0[3], s1[1]); ma = max3f(ma, s1[2], s1[3]);
#pragma unroll
            for (int r = 4; r < 16; r += 4) { ma = max3f(ma, s0[r], s0[r + 1]); mb = max3f(mb, s0[r + 2], s0[r + 3]); ma = max3f(ma, s1[r], s1[r + 1]); mb = max3f(mb, s1[r + 2], s1[r + 3]); }
            float mx = max2f_pad(ma, mb);
            { auto rr = __builtin_amdgcn_permlane32_swap(__float_as_uint(mx), __float_as_uint(mx), false, false); mx = fmaxf(__uint_as_float(rr[0]), __uint_as_float(rr[1])); }
            const bool first = (u == 0) && (h == 0);
            if (__builtin_expect(first || __any(mx > 7.5f), 0)) {
                const float d = first ? mx - 6.f : fmaxf(mx - 6.f, 0.f);
                mref += d;
                const float f = __builtin_amdgcn_exp2f(-d);
#pragma unroll
                for (int r = 0; r < 16; ++r) { s0[r] -= d; s1[r] -= d; o0[r] *= f; o1[r] *= f; lacc[r] *= f; negm[r] = -mref; }
                AT_PIN(negm);
            }
#pragma unroll
            for (int r = 0; r < 16; ++r) { s0[r] = __builtin_amdgcn_exp2f(s0[r]); s1[r] = __builtin_amdgcn_exp2f(s1[r]); }
            pack32_fp8_into(PP, s0, s1);
            { const u32x4 v00 = *(const u32x4*)(vb), v01 = *(const u32x4*)(vb + 1024), v10 = *(const u32x4*)(vb + 2048), v11 = *(const u32x4*)(vb + 3072);
              const i32x8 V0 = {(int)v00.x, (int)v00.y, (int)v00.z, (int)v00.w, (int)v01.x, (int)v01.y, (int)v01.z, (int)v01.w};
              const i32x8 V1 = {(int)v10.x, (int)v10.y, (int)v10.z, (int)v10.w, (int)v11.x, (int)v11.y, (int)v11.z, (int)v11.w};
              o0 = mfma8v(V0, PP, o0); o1 = mfma8v(V1, PP, o1); lacc = mfma8v(ONES, PP, lacc); }
        }
        if (pf) AT_WAIT_BAR(5); else AT_WAIT_BAR(0);
        slot = slot == 2 ? 0 : slot + 1;
    }
    const float inv = 1.f / lacc[0];
    const int tok = tq0 + r32;
    const bf16_t* sz = (const bf16_t*)(p.ws + WS_SZ) + (size_t)tok * AW + head * 64 + 8 * hi;
    bf16_t* mo = (bf16_t*)(p.ws + WS_MIX2) + (size_t)tok * AW + head * 64 + 8 * hi;
#pragma unroll
    for (int d0 = 0; d0 < 2; ++d0)
#pragma unroll
        for (int q8 = 0; q8 < 2; ++q8) {
            const u32x4 g = *(const u32x4*)(sz + 32 * d0 + 16 * q8);
            float v[8];
#pragma unroll
            for (int e = 0; e < 4; ++e) {
                const float a = d0 == 0 ? o0[8 * q8 + 2 * e] : o1[8 * q8 + 2 * e], b = d0 == 0 ? o0[8 * q8 + 2 * e + 1] : o1[8 * q8 + 2 * e + 1];
                v[2 * e] = a * inv * bf_lo(g[e]); v[2 * e + 1] = b * inv * bf_hi(g[e]);
            }
            *(u32x4*)(mo + 32 * d0 + 16 * q8) = pack8(v);
        }
}


constexpr size_t WS_BAR = 640 * 1024;
#define XB_TMO      128
#define XB_XCNT(j)  (256  + 64 * (j))
#define XB_XSUB(j)  (1280 + 64 * (j))
#define XB_XGEN(j)  (2304 + 64 * (j))
#define XB_TOP      3328
#define XB_TOPGEN   3392
#define XCD_BAR_WORDS 3456
#define XB_SPIN_CAP (1u << 18)
__device__ __forceinline__ unsigned xb_ld(unsigned* p)              { return __hip_atomic_load(p, __ATOMIC_RELAXED, __HIP_MEMORY_SCOPE_AGENT); }
__device__ __forceinline__ unsigned xb_add(unsigned* p, unsigned v) { return __hip_atomic_fetch_add(p, v, __ATOMIC_RELAXED, __HIP_MEMORY_SCOPE_AGENT); }
__device__ __forceinline__ unsigned xb_xcc_id() { return (unsigned)__builtin_amdgcn_s_getreg((3 << 11) | 20) & 0xFu; }
#define XB_SPIN(cond, bar) do { unsigned _sp = 0; while (cond) { __builtin_amdgcn_s_sleep(1); \
    if ((++_sp & 255u) == 0u) { if (xb_ld(&(bar)[XB_TMO])) break; if (_sp > XB_SPIN_CAP) { atomicAdd(&(bar)[XB_TMO], 1u); break; } } } } while (0)
struct XcdBarrier { unsigned* bar; unsigned x; unsigned nloc, nx; };
__device__ __forceinline__ XcdBarrier xcd_barrier_post(unsigned* bar) {
    XcdBarrier b; b.bar = bar; b.x = xb_xcc_id(); b.nloc = 0u; b.nx = 0u;
    if (threadIdx.x == 0) (void)xb_add(&bar[XB_XCNT(b.x)], 1u);
    return b;
}
__device__ __forceinline__ void xcd_barrier_complete(unsigned* bar, unsigned x, unsigned& nloc, unsigned& nx) {
    const unsigned G = gridDim.x * gridDim.y * gridDim.z;
    unsigned sum, cnt, mine, sp = 0u;
    for (;;) {
        sum = 0u; cnt = 0u; mine = 0u;
#pragma unroll
        for (unsigned j = 0; j < 16; ++j) { const unsigned c = xb_ld(&bar[XB_XCNT(j)]); sum += c; cnt += (c > 0u) ? 1u : 0u; mine = (j == x) ? c : mine; }
        if (sum == G) break;
        __builtin_amdgcn_s_sleep(1);
        if ((++sp & 255u) == 0u) { if (xb_ld(&bar[XB_TMO])) break; if (sp > XB_SPIN_CAP) { atomicAdd(&bar[XB_TMO], 1u); break; } }
    }
    nloc = mine > 0u ? mine : 1u; nx = cnt > 0u ? cnt : 1u;
}
__device__ __forceinline__ void xcd_barrier(XcdBarrier& b) {
    asm volatile("s_waitcnt vmcnt(0)" ::: "memory");
    __syncthreads();
    if (threadIdx.x == 0) {
        unsigned* bar = b.bar;
        __builtin_amdgcn_s_waitcnt(0);
        unsigned nloc = b.nloc, nx = b.nx;
        if (nloc == 0u) { xcd_barrier_complete(bar, b.x, nloc, nx); b.nloc = nloc; b.nx = nx; }
        const unsigned old = xb_add(&bar[XB_XSUB(b.x)], 1u);
        const unsigned gen = old / nloc;
        if (old + 1u == (gen + 1u) * nloc) {
            __builtin_amdgcn_fence(__ATOMIC_RELEASE, "agent");
            asm volatile("s_waitcnt vmcnt(0)" ::: "memory");
            const unsigned og = xb_add(&bar[XB_TOP], 1u);
            const unsigned tg = og / nx;
            if (og + 1u == (tg + 1u) * nx) xb_add(&bar[XB_TOPGEN], 1u);
            else XB_SPIN(xb_ld(&bar[XB_TOPGEN]) == tg, bar);
            __builtin_amdgcn_fence(__ATOMIC_ACQUIRE, "agent");
            xb_add(&bar[XB_XGEN(b.x)], 1u);
            asm volatile("s_waitcnt vmcnt(0)" ::: "memory");
        } else {
            XB_SPIN(xb_ld(&bar[XB_XGEN(b.x)]) == gen, bar);
            __builtin_amdgcn_fence(__ATOMIC_ACQUIRE, "agent");
            asm volatile("s_waitcnt vmcnt(0)" ::: "memory");
        }
    }
    __syncthreads();
}

__global__ void __launch_bounds__(NTHR, 2) fwd_kernel(Params p) {
    extern __shared__ __attribute__((aligned(16))) unsigned char lds[];
    cg::grid_group grid = cg::this_grid();
    const int G = gridDim.x, bx = blockIdx.x, tid = threadIdx.x;
    const int gtid = bx * NTHR + tid, gthreads = G * NTHR;
    const int xcd = bx & 7, lb = bx >> 3, GX = G >> 3;
    unsigned char* ws = p.ws;

    __syncthreads();
    XcdBarrier xbar = xcd_barrier_post((unsigned*)(ws + WS_BAR));
    if (p.ws == nullptr) grid.sync();
    phase0(p, gtid, gthreads);
    xcd_barrier(xbar);

    { EpiIn E{ws}; const bf16_t* xn = (const bf16_t*)(ws + WS_XN); const bf16_t* W = (const bf16_t*)(ws + WS_WIN);
      gemm_dma<4, 2, 0>(lds, xn, xn, 1 << 30, DM, W, DM, 13, xcd, lb, GX, E); }
    xcd_barrier(xbar);

    { EpiQ E{ws}; const bf16_t* A = (const bf16_t*)(ws + WS_QLAT); const bf16_t* W = (const bf16_t*)(ws + WS_WUQ);
      gemm_dma<2, 3, 0>(lds, A, A, 1 << 30, QLR, W, QLR, 2, xcd, lb, GX, E); }
    { EpiKV E{ws}; const bf16_t* A = (const bf16_t*)(ws + WS_KVLAT); const bf16_t* W = (const bf16_t*)(ws + WS_WUKV);
      gemm_dma<4, 2, 1>(lds, A, A, 1 << 30, KVLR, W, KVLR, 4, xcd, lb, GX, E); }
    conv_phase(p, gtid, gthreads);
    xcd_barrier(xbar);

    for (int w = lb; w < 128; w += GX) { const int bl = w >> 6, qblk = w & 63; attn_unit(lds, p, xcd, NTOK_P + bl * SEQ_S, SEQ_S, qblk); }
    { unsigned* tick = (unsigned*)(ws + WS_BAR) + 3584 + 64 * xcd;
      for (;;) {
          if (tid == 0) *(volatile unsigned*)lds = xb_add(tick, 1u);
          __syncthreads();
          const unsigned w2 = *(volatile unsigned*)lds;
          __syncthreads();
          if (w2 >= 64u) break;
          attn_unit(lds, p, (int)(w2 >> 3), xcd * SEQ_P, SEQ_P, (int)(w2 & 7));
      } }
    xcd_barrier(xbar);

    { EpiOut E{ws}; const bf16_t* A0 = (const bf16_t*)(ws + WS_MIXA); const bf16_t* A1 = (const bf16_t*)(ws + WS_MIX2); const bf16_t* W = (const bf16_t*)(ws + WS_WOUT);
      gemm_dma<4, 2, 0>(lds, A0, A1, 512, CW, W, DM, 4, xcd, lb, GX, E); }
    xcd_barrier(xbar);

    { const float* ssq = (const float*)(ws + WS_SSQ) + 2 * NTOK; const bf16_t* ob = (const bf16_t*)(ws + WS_XN);
      const int lane = tid & 63, gw = gtid >> 6, nw = gthreads >> 6;
      f32x4 g[4];
#pragma unroll
      for (int j = 0; j < 4; ++j) g[j] = *(const f32x4*)(p.norm_post + 4 * lane + 256 * j);
      for (int row = gw * 2; row < NTOK; row += nw * 2) {
          f32x4 xv[2][4]; u32x2 ov[2][4]; float rs[2];
#pragma unroll
          for (int u = 0; u < 2; ++u) {
              const float* xr = xrow(p, row + u) + 4 * lane; const bf16_t* orow = ob + (size_t)(row + u) * DM + 4 * lane;
#pragma unroll
              for (int j = 0; j < 4; ++j) { xv[u][j] = __builtin_nontemporal_load((const f32x4*)(xr + 256 * j)); ov[u][j] = __builtin_nontemporal_load((const u32x2*)(orow + 256 * j)); }
              rs[u] = rsqrtf(ssq[row + u] * (1.f / DM) + EPS);
          }
#pragma unroll
          for (int u = 0; u < 2; ++u) {
              float* yr = p.out + (size_t)(row + u) * DM + 4 * lane;
#pragma unroll
              for (int j = 0; j < 4; ++j) {
                  f32x4 o; o.x = bf_lo(ov[u][j].x); o.y = bf_hi(ov[u][j].x); o.z = bf_lo(ov[u][j].y); o.w = bf_hi(ov[u][j].y);
                  __builtin_nontemporal_store(xv[u][j] + o * rs[u] * g[j], (f32x4*)(yr + 256 * j));
              }
          }
      } }
}

extern "C" void kernel_launch(void* const* d_in, const int* in_sizes, int n_in, void* d_out, int out_size, void* d_ws, size_t ws_size, hipStream_t stream) {
    static int grid_blocks = 0;
    if (!grid_blocks) {
        int dev = 0, cus = 0, per_cu = 0;
        hipGetDevice(&dev);
        hipDeviceGetAttribute(&cus, hipDeviceAttributeMultiprocessorCount, dev);
        hipFuncSetAttribute((const void*)fwd_kernel, hipFuncAttributeMaxDynamicSharedMemorySize, LDS_BYTES);
        hipOccupancyMaxActiveBlocksPerMultiprocessor(&per_cu, (const void*)fwd_kernel, NTHR, LDS_BYTES);
        if (per_cu < 1) per_cu = 1;
        if (per_cu > 1) per_cu = 1;
        grid_blocks = cus * per_cu;
        if (ws_size < WS_END) fprintf(stderr, "kernel_launch: workspace too small (%zu < %zu)\n", ws_size, (size_t)WS_END);
    }
    (void)hipMemsetAsync((unsigned char*)d_ws + WS_BAR, 0, 16384, stream);
    Params p{};
    p.x_prompt = (const float*)d_in[0]; p.x_sample = (const float*)d_in[1]; p.norm_pre = (const float*)d_in[2]; p.w_in = (const float*)d_in[3];
    p.conv_w = (const float*)d_in[4]; p.q_norm = (const float*)d_in[5]; p.w_uq = (const float*)d_in[6]; p.kv_norm = (const float*)d_in[7];
    p.w_ukv = (const float*)d_in[8]; p.w_out = (const float*)d_in[9]; p.norm_post = (const float*)d_in[10];
    p.out = (float*)d_out; p.ws = (unsigned char*)d_ws;
    void* args[] = {&p};
    hipError_t e = hipLaunchCooperativeKernel((const void*)fwd_kernel, dim3(grid_blocks), dim3(NTHR), args, LDS_BYTES, stream);
    if (e != hipSuccess) fprintf(stderr, "cooperative launch failed: %s (grid %d)\n", hipGetErrorString(e), grid_blocks);
}
```

```cpp
#include <hip/hip_runtime.h>
#include <hip/hip_cooperative_groups.h>
#include <cstdio>
#include <cstdint>
namespace cg = cooperative_groups;

typedef unsigned short bf16_t;
typedef short bf16x8 __attribute__((ext_vector_type(8)));
typedef float f32x16 __attribute__((ext_vector_type(16)));
typedef float f32x4 __attribute__((ext_vector_type(4)));
typedef float f32x2 __attribute__((ext_vector_type(2)));
typedef unsigned u32x4 __attribute__((ext_vector_type(4)));
typedef unsigned u32x2 __attribute__((ext_vector_type(2)));
#define LAS __attribute__((address_space(3)))

constexpr int DM = 1024, NTOK = 49152, NTOK_P = 16384, SEQ_P = 2048, SEQ_S = 16384;
constexpr int CW = 512, NH = 8, QLR = 384, KVLR = 256, ROPE = 32, AW = 512;
constexpr int NIN = 3328;
constexpr int NBLK32 = NTOK / 32;
constexpr float EPS = 1e-6f;
constexpr float C2 = 0.14724444f;

constexpr size_t MiB = 1u << 20;
constexpr size_t WS_SSQ = 0;
constexpr size_t WS_COS = 1 * MiB, WS_SIN = 2 * MiB;
constexpr size_t WS_WIN = 3 * MiB;
constexpr size_t WS_WUQ = 10 * MiB;
constexpr size_t WS_WUKV = 11 * MiB;
constexpr size_t WS_WOUT = 12 * MiB;
constexpr size_t WS_XN = 16 * MiB;
constexpr size_t WS_QF = 16 * MiB;
constexpr size_t WS_CU = 112 * MiB;
constexpr size_t WS_GZ = 160 * MiB;
constexpr size_t WS_SZ = 208 * MiB;
constexpr size_t WS_QLAT = 256 * MiB;
constexpr size_t WS_KVLAT = 292 * MiB;
constexpr size_t WS_MIX2 = 256 * MiB;
constexpr size_t WS_KF = 316 * MiB;
constexpr size_t WS_VF = 388 * MiB;
constexpr size_t WS_MIXA = 436 * MiB;
constexpr size_t WS_END = 484 * MiB;

constexpr int LDS_BYTES = 131072;
constexpr int NTHR = 512;

struct Params {
    const float* x_prompt; const float* x_sample; const float* norm_pre; const float* w_in; const float* conv_w;
    const float* q_norm; const float* w_uq; const float* kv_norm; const float* w_ukv; const float* w_out; const float* norm_post;
    float* out; unsigned char* ws;
};

__device__ __forceinline__ unsigned pk_bf16(float lo, float hi) {
    typedef __bf16 b2 __attribute__((ext_vector_type(2)));
    f32x2 v = {lo, hi}; b2 b = __builtin_convertvector(v, b2); return __builtin_bit_cast(unsigned, b);
}
__device__ __forceinline__ float bf_lo(unsigned u) { return __uint_as_float(u << 16); }
__device__ __forceinline__ float bf_hi(unsigned u) { return __uint_as_float(u & 0xffff0000u); }
__device__ __forceinline__ u32x4 pack8(const float* v) {
    u32x4 w; w.x = pk_bf16(v[0], v[1]); w.y = pk_bf16(v[2], v[3]); w.z = pk_bf16(v[4], v[5]); w.w = pk_bf16(v[6], v[7]); return w;
}
typedef int i32x8 __attribute__((ext_vector_type(8)));
__device__ __forceinline__ u32x4 pack16_fp8(const float* v) {
    u32x4 w;
#pragma unroll
    for (int k = 0; k < 4; ++k) { int t = __builtin_amdgcn_cvt_pk_fp8_f32(v[4 * k], v[4 * k + 1], 0, false); t = __builtin_amdgcn_cvt_pk_fp8_f32(v[4 * k + 2], v[4 * k + 3], t, true); w[k] = (unsigned)t; }
    return w;
}
__device__ __forceinline__ f32x16 mfma8(u32x4 a0, u32x4 a1, u32x4 b0, u32x4 b1, f32x16 c) {
    const i32x8 A = {(int)a0.x, (int)a0.y, (int)a0.z, (int)a0.w, (int)a1.x, (int)a1.y, (int)a1.z, (int)a1.w};
    const i32x8 B = {(int)b0.x, (int)b0.y, (int)b0.z, (int)b0.w, (int)b1.x, (int)b1.y, (int)b1.z, (int)b1.w};
    return __builtin_amdgcn_mfma_scale_f32_32x32x64_f8f6f4(A, B, c, 0, 0, 0, 0x7f7f7f7f, 0, 0x7f7f7f7f);
}
__device__ __forceinline__ f32x16 mfma8v(i32x8 A, i32x8 B, f32x16 c) { return __builtin_amdgcn_mfma_scale_f32_32x32x64_f8f6f4(A, B, c, 0, 0, 0, 0x7f7f7f7f, 0, 0x7f7f7f7f); }
__device__ __forceinline__ void pack32_fp8_into(i32x8& P, const f32x16& s0, const f32x16& s1) {
#pragma unroll
    for (int k = 0; k < 4; ++k) { int t = __builtin_amdgcn_cvt_pk_fp8_f32(s0[4 * k], s0[4 * k + 1], P[k], false); P[k] = __builtin_amdgcn_cvt_pk_fp8_f32(s0[4 * k + 2], s0[4 * k + 3], t, true); }
#pragma unroll
    for (int k = 0; k < 4; ++k) { int t = __builtin_amdgcn_cvt_pk_fp8_f32(s1[4 * k], s1[4 * k + 1], P[4 + k], false); P[4 + k] = __builtin_amdgcn_cvt_pk_fp8_f32(s1[4 * k + 2], s1[4 * k + 3], t, true); }
}
__device__ __forceinline__ float silu_f(float z) { return z / (1.f + __expf(-z)); }
__device__ __forceinline__ int cperm(int p) { const int hp = (p >> 2) & 1, r = (p & 3) + 4 * (p >> 3); return 16 * (r >> 3) + 8 * hp + (r & 7); }
__device__ __forceinline__ int crow(int r, int hi) { return (r & 3) + 8 * (r >> 2) + 4 * hi; }
__device__ __forceinline__ float swap32_max(float m) {
    auto rr = __builtin_amdgcn_permlane32_swap(__float_as_uint(m), __float_as_uint(m), false, false);
    return fmaxf(__uint_as_float(rr[0]), __uint_as_float(rr[1]));
}
__device__ __forceinline__ float swap32_sum(float m) {
    auto rr = __builtin_amdgcn_permlane32_swap(__float_as_uint(m), __float_as_uint(m), false, false);
    return __uint_as_float(rr[0]) + __uint_as_float(rr[1]);
}
__device__ __forceinline__ float wave_sum(float v) {
#pragma unroll
    for (int o = 1; o < 64; o <<= 1) v += __shfl_xor(v, o);
    return v;
}
__device__ __forceinline__ const float* xrow(const Params& p, int tok) {
    return tok < NTOK_P ? p.x_prompt + (size_t)tok * DM : p.x_sample + (size_t)(tok - NTOK_P) * DM;
}
__device__ __forceinline__ int tok_pos(int tok) { return tok < NTOK_P ? (tok & (SEQ_P - 1)) : (tok & (SEQ_S - 1)); }

__device__ __forceinline__ void glds16(const void* gsrc, unsigned lds_dst) {
    unsigned keep;
    asm volatile("s_mov_b32 %0, m0\n\ts_mov_b32 m0, %2\n\ts_nop 0\n\tglobal_load_lds_dwordx4 %1, off\n\ts_mov_b32 m0, %0" : "=&s"(keep) : "v"(gsrc), "s"(lds_dst) : "memory");
}
#define AT_WAIT_BAR(N) asm volatile("s_waitcnt vmcnt(" #N ") lgkmcnt(0)\n\ts_barrier" ::: "memory")
typedef __amdgpu_buffer_rsrc_t srd_t;
__device__ __forceinline__ srd_t make_srd(const void* base) { return __builtin_amdgcn_make_buffer_rsrc((void*)base, (short)0, 0x7ffffffe, 0x00020000); }
__device__ __forceinline__ void bdma16(unsigned m0v, unsigned voff, srd_t srd, unsigned soff) {
    asm volatile("s_nop 4\n\ts_mov_b32 m0, %0\n\ts_nop 0\n\tbuffer_load_dwordx4 %1, %2, %3 offen lds" :: "s"(m0v), "v"(voff), "s"(srd), "s"(soff) : "m0", "memory");
}
__device__ __forceinline__ unsigned rflu(unsigned v) { return (unsigned)__builtin_amdgcn_readfirstlane((int)v); }

__device__ __forceinline__ int win_src(int np) {
    const int T = np >> 7, w = np & 127;
    if (T < 16) { const int wn = w >> 6, j = (w >> 5) & 1, q = (w >> 4) & 1, i16 = w & 15; return (2 * j + q) * 512 + 32 * T + 16 * wn + i16; }
    if (T < 21) return np;
    if (T < 25) return 2720 + (np - 2688);
    return w < 32 ? 2688 + w : -1;
}
template <int MODE>
__device__ __forceinline__ void prep_weight(const float* __restrict__ w, const float* __restrict__ gain, bf16_t* WT, int K, int Nsrc, int Ndst, int gtid, int gthreads) {
    const int items = Ndst * (K / 8);
    for (int id = gtid; id < items; id += gthreads) {
        const int n = id % Ndst, kc = id / Ndst, k0 = kc * 8;
        const int src = (MODE == 1) ? win_src(n) : n;
        float v[8];
#pragma unroll
        for (int e = 0; e < 8; ++e) v[e] = (src >= 0) ? w[(size_t)(k0 + e) * Nsrc + src] * (gain ? gain[k0 + e] : 1.f) : 0.f;
        *(u32x4*)(WT + (size_t)n * K + k0) = pack8(v);
    }
}
__device__ __forceinline__ void rope_entry(int pos, int i, float& c, float& s) {
    const int a = i & 3, b = i >> 2;
    double base = a == 0 ? 1.0 : a == 1 ? 0.5623413251903491 : a == 2 ? 0.31622776601683794 : 0.1778279410038923;
    double sc = b == 0 ? 1.0 : b == 1 ? 0.1 : b == 2 ? 0.01 : 0.001;
    const float freq = (float)(base * sc);
    const float angf = (float)pos * freq;
    const double x = (double)angf;
    const double kq = rint(x * 0.6366197723675814);
    const double r = (x - kq * 1.5707963267948966) - kq * 6.123233995736766e-17;
    const double r2 = r * r;
    const double sn = r * (1.0 + r2 * (-1.0 / 6 + r2 * (1.0 / 120 + r2 * (-1.0 / 5040 + r2 * (1.0 / 362880 + r2 * (-1.0 / 39916800))))));
    const double cs = 1.0 + r2 * (-0.5 + r2 * (1.0 / 24 + r2 * (-1.0 / 720 + r2 * (1.0 / 40320 + r2 * (-1.0 / 3628800 + r2 * (1.0 / 479001600))))));
    const int qd = ((int)kq) & 3;
    const double so = qd == 0 ? sn : qd == 1 ? cs : qd == 2 ? -sn : -cs;
    const double co = qd == 0 ? cs : qd == 1 ? -sn : qd == 2 ? -cs : sn;
    c = (float)co; s = (float)so;
}
__device__ __forceinline__ void phase0(const Params& p, int gtid, int gthreads) {
    unsigned char* ws = p.ws;
    float* ssq = (float*)(ws + WS_SSQ);
    for (int i = gtid; i < 3 * NTOK; i += gthreads) ssq[i] = 0.f;
    float* ct = (float*)(ws + WS_COS); float* st = (float*)(ws + WS_SIN);
    for (int i = gtid; i < SEQ_S * 16; i += gthreads) { float c, s; rope_entry(i >> 4, i & 15, c, s); ct[i] = c; st[i] = s; }
    prep_weight<1>(p.w_in, p.norm_pre, (bf16_t*)(ws + WS_WIN), DM, 3232, NIN, gtid, gthreads);
    prep_weight<0>(p.w_uq, p.q_norm, (bf16_t*)(ws + WS_WUQ), QLR, 768, 768, gtid, gthreads);
    prep_weight<0>(p.w_ukv, p.kv_norm, (bf16_t*)(ws + WS_WUKV), KVLR, 1024, 1024, gtid, gthreads);
    prep_weight<0>(p.w_out, nullptr, (bf16_t*)(ws + WS_WOUT), DM, 1024, 1024, gtid, gthreads);
    const int gw = gtid >> 6, nw = gthreads >> 6, lane = threadIdx.x & 63;
    bf16_t* xn = (bf16_t*)(ws + WS_XN);
    for (int row = gw * 2; row < NTOK; row += nw * 2) {
        f32x4 v[2][4]; float s[2];
#pragma unroll
        for (int u = 0; u < 2; ++u) {
            const f32x4* xr = (const f32x4*)xrow(p, row + u) + lane; s[u] = 0.f;
#pragma unroll
            for (int j = 0; j < 4; ++j) { v[u][j] = __builtin_nontemporal_load(xr + 64 * j); }
        }
#pragma unroll
        for (int u = 0; u < 2; ++u) {
#pragma unroll
            for (int j = 0; j < 4; ++j) s[u] += (v[u][j].x * v[u][j].x + v[u][j].y * v[u][j].y) + (v[u][j].z * v[u][j].z + v[u][j].w * v[u][j].w);
            const float rs = rsqrtf(wave_sum(s[u]) * (1.f / DM) + EPS);
            u32x2* o = (u32x2*)(xn + (size_t)(row + u) * DM) + lane;
#pragma unroll
            for (int j = 0; j < 4; ++j) { u32x2 w; w.x = pk_bf16(v[u][j].x * rs, v[u][j].y * rs); w.y = pk_bf16(v[u][j].z * rs, v[u][j].w * rs); o[64 * j] = w; }
        }
    }
}

__device__ __forceinline__ void tile_map(int w, int NT, int xcd, int MPX, int& mt, int& nt) {
    const int g = w / (8 * NT), rem = w % (8 * NT);
    nt = rem >> 3; mt = xcd * MPX + g * 8 + (rem & 7);
}
template <int MI, int NJ, int MODE, class Epi>
__device__ __forceinline__ void gemm_dma(unsigned char* lds, const bf16_t* __restrict__ A0, const bf16_t* __restrict__ A1, int ksplit, int lda,
                                         const bf16_t* __restrict__ Bt, int K, int NT, int xcd, int lb, int GX, const Epi& epi) {
    constexpr int NSA = 4 * MI, NSUB = 4 * MI + 8 * NJ, STAGE = NSUB * 1024, NIT = NSUB / 8, NITA = NSA / 8, BOFF = NSA * 1024, MPX = 96 / MI;
    static_assert(4 * STAGE <= LDS_BYTES && NSUB % 8 == 0 && NSA % 8 == 0, "lds");
    const int tid = threadIdx.x, lane = tid & 63, wid = __builtin_amdgcn_readfirstlane(tid >> 6), wm = wid >> 2, wn = wid & 3;
    const int r32 = lane & 31, hi = lane >> 5;
    const unsigned lds0 = rflu((unsigned)(uintptr_t)lds);
    const int nk = K / 32, count = MPX * NT;
    int w = lb;
    if (w >= count) return;
    int mt, nt; tile_map(w, NT, xcd, MPX, mt, nt);
    const int rowl = lane >> 2, colsw = 8 * ((lane & 3) ^ ((lane >> 4) & 3));
    const unsigned voffA = (unsigned)((rowl * lda + colsw) * 2), voffB = (unsigned)((rowl * K + colsw) * 2);
    const srd_t srdA0 = make_srd(A0), srdA1 = make_srd(A1), srdB = make_srd(Bt);
    auto dma = [&](int tmt, int tnt, int kt, int stage) {
        const int k0 = kt * 32;
        const bool lo = k0 < ksplit;
        const unsigned sa = (unsigned)(tmt * 64 * MI) * (unsigned)(lda * 2) + (unsigned)((lo ? k0 : k0 - ksplit) * 2);
        const unsigned sbb = (unsigned)(tnt * 128 * NJ) * (unsigned)(K * 2) + (unsigned)(k0 * 2);
#pragma unroll
        for (int it = 0; it < NIT; ++it) {
            const int f = wid + 8 * it;
            const unsigned m0v = rflu(lds0 + (unsigned)(stage * STAGE + f * 1024));
            if (it < NITA) { const unsigned so = rflu(sa + (unsigned)(f * 16) * (unsigned)(lda * 2)); if (lo) bdma16(m0v, voffA, srdA0, so); else bdma16(m0v, voffA, srdA1, so); }
            else { const unsigned so = rflu(sbb + (unsigned)((f - NSA) * 16) * (unsigned)(K * 2)); bdma16(m0v, voffB, srdB, so); }
        }
    };
    const int cb = cperm(r32);
    const int arow = (wm * 32 * MI + r32), brow = (wn * 32 * NJ + cb);
    const int abase = (arow >> 4) * 1024 + (arow & 15) * 64, ax = (arow >> 2) & 3;
    const int bbase = BOFF + (brow >> 4) * 1024 + (brow & 15) * 64, bx_ = (brow >> 2) & 3;
    const bool swp = (MODE == 0) || ((wn & 1) == 0);
    f32x16 acc[MI][NJ];
    auto compute = [&](int stage) {
        const unsigned char* base = lds + stage * STAGE;
#pragma unroll
        for (int kk = 0; kk < 2; ++kk) {
            bf16x8 af[MI], bfr[NJ];
            const int ca = ((2 * kk + hi) ^ ax) << 4, cbb = ((2 * kk + hi) ^ bx_) << 4;
#pragma unroll
            for (int i = 0; i < MI; ++i) af[i] = *(const bf16x8*)(base + abase + i * 2048 + ca);
#pragma unroll
            for (int j = 0; j < NJ; ++j) bfr[j] = *(const bf16x8*)(base + bbase + j * 2048 + cbb);
#pragma unroll
            for (int i = 0; i < MI; ++i)
#pragma unroll
                for (int j = 0; j < NJ; ++j) {
                    if (MODE == 0) acc[i][j] = __builtin_amdgcn_mfma_f32_32x32x16_bf16(bfr[j], af[i], acc[i][j], 0, 0, 0);
                    else { const bf16x8 xa = swp ? bfr[j] : af[i], xb = swp ? af[i] : bfr[j]; acc[i][j] = __builtin_amdgcn_mfma_f32_32x32x16_bf16(xa, xb, acc[i][j], 0, 0, 0); }
                }
        }
    };
    auto dma2 = [&](int tmt, int tnt, int kt2, int sb) { dma(tmt, tnt, 2 * kt2, 2 * sb); dma(tmt, tnt, 2 * kt2 + 1, 2 * sb + 1); };
    dma2(mt, nt, 0, 0);
    int sb = 0;
    const int nk2 = nk >> 1;
    for (;;) {
        const int wnx = w + GX; const bool has_next = wnx < count;
        int mt2 = mt, nt2 = nt; if (has_next) tile_map(wnx, NT, xcd, MPX, mt2, nt2);
#pragma unroll
        for (int i = 0; i < MI; ++i)
#pragma unroll
            for (int j = 0; j < NJ; ++j)
#pragma unroll
                for (int r = 0; r < 16; ++r) acc[i][j][r] = 0.f;
        AT_WAIT_BAR(0);
        for (int kt2 = 0; kt2 < nk2; ++kt2) {
            const bool last = kt2 + 1 == nk2;
            if (wm == 0) { if (!last) dma2(mt, nt, kt2 + 1, sb ^ 1); else if (has_next) dma2(mt2, nt2, 0, sb ^ 1); }
            compute(2 * sb);
            if (wm != 0) { if (!last) dma2(mt, nt, kt2 + 1, sb ^ 1); else if (has_next) dma2(mt2, nt2, 0, sb ^ 1); }
            compute(2 * sb + 1);
            if (!last) AT_WAIT_BAR(0);
            sb ^= 1;
        }
        epi(acc, mt, nt * 2 + (wn >> 1), wm, wn & 1, r32, hi);
        if (!has_next) break;
        w = wnx; mt = mt2; nt = nt2;
    }
    AT_WAIT_BAR(0);
}

struct EpiIn {
    unsigned char* ws;
    template <int MI> __device__ __forceinline__ void operator()(f32x16 (&acc)[MI][2], int mt, int nt, int wm, int wn, int r32, int hi) const {
        const int lane = r32 + 32 * hi;
        if (nt < 16) {
            bf16_t* cu = (bf16_t*)(ws + WS_CU); bf16_t* gz = (bf16_t*)(ws + WS_GZ);
#pragma unroll
            for (int i = 0; i < MI; ++i) {
                const int tok = mt * (64 * MI) + wm * (32 * MI) + 32 * i + r32; const int ch0 = 32 * nt + 16 * wn + 8 * hi;
                float a[8], b[8];
#pragma unroll
                for (int e = 0; e < 8; ++e) { const float u = acc[i][0][e], B = acc[i][0][8 + e], C = acc[i][1][e], z = acc[i][1][8 + e]; a[e] = C * u; b[e] = B * silu_f(z); }
                *(u32x4*)(cu + (size_t)tok * CW + ch0) = pack8(a);
                *(u32x4*)(gz + (size_t)tok * CW + ch0) = pack8(b);
            }
        } else if (nt < 21) {
            const bool isq = nt < 19;
            bf16_t* dst = (bf16_t*)(ws + (isq ? WS_QLAT : WS_KVLAT)); const int ld = isq ? QLR : KVLR; const int cb = (isq ? (nt - 16) : (nt - 19)) * 128 + wn * 64 + 8 * hi;
            float* ssq = (float*)(ws + WS_SSQ) + (isq ? 0 : NTOK);
#pragma unroll
            for (int i = 0; i < MI; ++i) {
                const int tok = mt * (64 * MI) + wm * (32 * MI) + 32 * i + r32; float ss = 0.f;
#pragma unroll
                for (int j = 0; j < 2; ++j)
#pragma unroll
                    for (int q = 0; q < 2; ++q) {
                        float v[8];
#pragma unroll
                        for (int e = 0; e < 8; ++e) { v[e] = acc[i][j][8 * q + e]; ss += v[e] * v[e]; }
                        *(u32x4*)(dst + (size_t)tok * ld + cb + 32 * j + 16 * q) = pack8(v);
                    }
                ss = swap32_sum(ss);
                if (hi == 0) atomicAdd(ssq + tok, ss);
            }
        } else if (nt < 25) {
            bf16_t* sz = (bf16_t*)(ws + WS_SZ); const int cb = (nt - 21) * 128 + wn * 64 + 8 * hi;
#pragma unroll
            for (int i = 0; i < MI; ++i) {
                const int tok = mt * (64 * MI) + wm * (32 * MI) + 32 * i + r32;
#pragma unroll
                for (int j = 0; j < 2; ++j)
#pragma unroll
                    for (int q = 0; q < 2; ++q) {
                        float v[8];
#pragma unroll
                        for (int e = 0; e < 8; ++e) v[e] = silu_f(acc[i][j][8 * q + e]);
                        *(u32x4*)(sz + (size_t)tok * AW + cb + 32 * j + 16 * q) = pack8(v);
                    }
            }
        } else if (wn == 0) {
            const float* ct = (const float*)(ws + WS_COS); const float* st = (const float*)(ws + WS_SIN);
            unsigned char* kf = ws + WS_KF;
#pragma unroll
            for (int i = 0; i < MI; ++i) {
                const int tok = mt * (64 * MI) + wm * (32 * MI) + 32 * i + r32; const int pos = tok_pos(tok);
                const f32x4 c0 = *(const f32x4*)(ct + pos * 16 + 8 * hi), c1 = *(const f32x4*)(ct + pos * 16 + 8 * hi + 4);
                const f32x4 s0 = *(const f32x4*)(st + pos * 16 + 8 * hi), s1 = *(const f32x4*)(st + pos * 16 + 8 * hi + 4);
                float o[16];
#pragma unroll
                for (int e = 0; e < 8; ++e) { const float c = e < 4 ? c0[e & 3] : c1[e & 3], s = e < 4 ? s0[e & 3] : s1[e & 3]; const float x1 = acc[i][0][e], x2 = acc[i][0][8 + e]; o[e] = x1 * c - x2 * s; o[8 + e] = x2 * c + x1 * s; }
                const u32x4 w1 = pack16_fp8(o); const int blk = tok >> 5;
#pragma unroll
                for (int h = 0; h < NH; ++h) *(u32x4*)(kf + ((size_t)(h * NBLK32 + blk) * 3 + 2) * 1024 + lane * 16) = w1;
            }
        }
    }
};
struct EpiQ {
    unsigned char* ws;
    template <int MI> __device__ __forceinline__ void operator()(f32x16 (&acc)[MI][3], int mt, int nt, int wm, int wn, int r32, int hi) const {
        const int lane = r32 + 32 * hi, head = nt * 2 + wn;
        const float* ssq = (const float*)(ws + WS_SSQ);
        const float* ct = (const float*)(ws + WS_COS); const float* st = (const float*)(ws + WS_SIN);
#pragma unroll
        for (int i = 0; i < MI; ++i) {
            const int tok = mt * (64 * MI) + wm * (32 * MI) + 32 * i + r32; const int pos = tok_pos(tok);
            const float rs = rsqrtf(__hip_atomic_load(ssq + tok, __ATOMIC_RELAXED, __HIP_MEMORY_SCOPE_AGENT) * (1.f / QLR) + EPS) * C2;
            unsigned char* d = ws + WS_QF + ((size_t)(head * NBLK32 + (tok >> 5)) * 3) * 1024 + lane * 16;
#pragma unroll
            for (int j = 0; j < 2; ++j) {
                float v[16];
#pragma unroll
                for (int r = 0; r < 16; ++r) v[r] = acc[i][j][r] * rs;
                *(u32x4*)(d + j * 1024) = pack16_fp8(v);
            }
            const f32x4 c0 = *(const f32x4*)(ct + pos * 16 + 8 * hi), c1 = *(const f32x4*)(ct + pos * 16 + 8 * hi + 4);
            const f32x4 s0 = *(const f32x4*)(st + pos * 16 + 8 * hi), s1 = *(const f32x4*)(st + pos * 16 + 8 * hi + 4);
            float o[16];
#pragma unroll
            for (int e = 0; e < 8; ++e) { const float c = e < 4 ? c0[e & 3] : c1[e & 3], s = e < 4 ? s0[e & 3] : s1[e & 3]; const float x1 = acc[i][2][e] * rs, x2 = acc[i][2][8 + e] * rs; o[e] = x1 * c - x2 * s; o[8 + e] = x2 * c + x1 * s; }
            *(u32x4*)(d + 2 * 1024) = pack16_fp8(o);
        }
    }
};
struct EpiKV {
    unsigned char* ws;
    template <int MI> __device__ __forceinline__ void operator()(f32x16 (&acc)[MI][2], int mt, int nt, int wm, int wn, int r32, int hi) const {
        static_assert(MI % 2 == 0, "V fragments pair two 32-token blocks");
        const int lane = r32 + 32 * hi, head = nt;
        const float* ssq = (const float*)(ws + WS_SSQ) + NTOK;
        if (wn == 0) {
#pragma unroll
            for (int i = 0; i < MI; ++i) {
                const int tok = mt * (64 * MI) + wm * (32 * MI) + 32 * i + r32;
                const float rs = rsqrtf(__hip_atomic_load(ssq + tok, __ATOMIC_RELAXED, __HIP_MEMORY_SCOPE_AGENT) * (1.f / KVLR) + EPS);
                unsigned char* d = ws + WS_KF + ((size_t)(head * NBLK32 + (tok >> 5)) * 3) * 1024 + lane * 16;
#pragma unroll
                for (int j = 0; j < 2; ++j) {
                    float v[16];
#pragma unroll
                    for (int r = 0; r < 16; ++r) v[r] = acc[i][j][r] * rs;
                    *(u32x4*)(d + j * 1024) = pack16_fp8(v);
                }
            }
        } else {
#pragma unroll
            for (int i = 0; i < MI; ++i) {
                const int tb = mt * (64 * MI) + wm * (32 * MI) + 32 * i;
                float rs[16];
#pragma unroll
                for (int r = 0; r < 16; ++r) rs[r] = rsqrtf(__hip_atomic_load(ssq + tb + crow(r, hi), __ATOMIC_RELAXED, __HIP_MEMORY_SCOPE_AGENT) * (1.f / KVLR) + EPS);
                unsigned char* d = ws + WS_VF + ((size_t)(head * (NTOK / 64) + (tb >> 6)) * 4) * 1024 + (i & 1) * 1024 + lane * 16;
#pragma unroll
                for (int j = 0; j < 2; ++j) {
                    float v[16];
#pragma unroll
                    for (int r = 0; r < 16; ++r) v[r] = acc[i][j][r] * rs[r];
                    *(u32x4*)(d + j * 2048) = pack16_fp8(v);
                }
            }
        }
    }
};
struct EpiOut {
    unsigned char* ws;
    template <int MI> __device__ __forceinline__ void operator()(f32x16 (&acc)[MI][2], int mt, int nt, int wm, int wn, int r32, int hi) const {
        float* ssq = (float*)(ws + WS_SSQ) + 2 * NTOK;
        bf16_t* ob = (bf16_t*)(ws + WS_XN);
#pragma unroll
        for (int i = 0; i < MI; ++i) {
            const int tok = mt * (64 * MI) + wm * (32 * MI) + 32 * i + r32; float ss = 0.f;
            bf16_t* d = ob + (size_t)tok * DM + nt * 128 + wn * 64 + 8 * hi;
#pragma unroll
            for (int j = 0; j < 2; ++j)
#pragma unroll
                for (int q = 0; q < 2; ++q) {
                    float v[8];
#pragma unroll
                    for (int e = 0; e < 8; ++e) { v[e] = acc[i][j][8 * q + e]; ss += v[e] * v[e]; }
                    *(u32x4*)(d + 32 * j + 16 * q) = pack8(v);
                }
            ss = swap32_sum(ss);
            if (hi == 0) atomicAdd(ssq + tok, ss);
        }
    }
};

__device__ __forceinline__ void conv_phase(const Params& p, int gtid, int gthreads) {
    const bf16_t* cu = (const bf16_t*)(p.ws + WS_CU); const bf16_t* gz = (const bf16_t*)(p.ws + WS_GZ); bf16_t* mixa = (bf16_t*)(p.ws + WS_MIXA);
    for (int id = gtid; id < NTOK * 64; id += gthreads) {
        const int tok = id >> 6, c0 = (id & 63) * 8, pos = tok_pos(tok), S = tok < NTOK_P ? SEQ_P : SEQ_S;
        const u32x4 z4 = {0u, 0u, 0u, 0u};
        const u32x4 cm = *(const u32x4*)(cu + (size_t)tok * CW + c0);
        const u32x4 cl = pos > 0 ? *(const u32x4*)(cu + (size_t)(tok - 1) * CW + c0) : z4;
        const u32x4 cr = pos < S - 1 ? *(const u32x4*)(cu + (size_t)(tok + 1) * CW + c0) : z4;
        const u32x4 g = *(const u32x4*)(gz + (size_t)tok * CW + c0);
        float w0[8], w1[8], w2[8], o[8];
#pragma unroll
        for (int e = 0; e < 8; ++e) { w0[e] = p.conv_w[c0 + e]; w1[e] = p.conv_w[CW + c0 + e]; w2[e] = p.conv_w[2 * CW + c0 + e]; }
#pragma unroll
        for (int e = 0; e < 4; ++e) {
            o[2 * e] = bf_lo(g[e]) * (w0[2 * e] * bf_lo(cl[e]) + w1[2 * e] * bf_lo(cm[e]) + w2[2 * e] * bf_lo(cr[e]));
            o[2 * e + 1] = bf_hi(g[e]) * (w0[2 * e + 1] * bf_hi(cl[e]) + w1[2 * e + 1] * bf_hi(cm[e]) + w2[2 * e + 1] * bf_hi(cr[e]));
        }
        *(u32x4*)(mixa + (size_t)tok * CW + c0) = pack8(o);
    }
}

constexpr int AT_STAGE = 40960, AT_NSLOT = 3;
static_assert(AT_NSLOT * AT_STAGE <= LDS_BYTES, "attention ring");
__device__ __forceinline__ float max3f(float a, float b, float c) { float r; asm("v_max3_f32 %0, %1, %2, %3" : "=v"(r) : "v"(a), "v"(b), "v"(c)); return r; }
__device__ __forceinline__ float max2f_pad(float a, float b) { float r; asm("v_max_f32_e32 %0, %1, %2\n\ts_nop 1" : "=v"(r) : "v"(a), "v"(b)); return r; }
#define AT_PIN(x) asm volatile("" : "+v"(x))
__device__ __forceinline__ void attn_dma(unsigned lds0, int slot, srd_t srdK, srd_t srdV, unsigned koff, unsigned voffs, int wid, int lane) {
#pragma unroll
    for (int it = 0; it < 5; ++it) {
        const int pc = wid + 8 * it;
        const unsigned m0v = rflu(lds0 + (unsigned)(slot * AT_STAGE + pc * 1024));
        if (it < 3) bdma16(m0v, (unsigned)lane * 16u, srdK, rflu(koff + (unsigned)pc * 1024u));
        else bdma16(m0v, (unsigned)lane * 16u, srdV, rflu(voffs + (unsigned)(pc - 24) * 1024u));
    }
}
__device__ __forceinline__ void attn_unit(unsigned char* lds, const Params& p, int head, int tok0, int S, int qblk) {
    const int tid = threadIdx.x, lane = tid & 63, wid = __builtin_amdgcn_readfirstlane(tid >> 6), r32 = lane & 31, hi = lane >> 5;
    const unsigned lds0 = rflu((unsigned)(uintptr_t)lds);
    const int tq0 = tok0 + qblk * 256 + wid * 32;
    const srd_t srdK = make_srd(p.ws + WS_KF), srdV = make_srd(p.ws + WS_VF);
    const unsigned koff0 = (unsigned)(head * NBLK32 + (tok0 >> 5)) * 3072u;
    const unsigned voff0 = (unsigned)(head * (NTOK / 64) + (tok0 >> 6)) * 4096u;
    const int NU = S / 256;
    attn_dma(lds0, 0, srdK, srdV, koff0, voff0, wid, lane);
    attn_dma(lds0, 1, srdK, srdV, koff0 + 24576u, voff0 + 16384u, wid, lane);
    u32x4 q0, q1, q2;
    { const unsigned char* qp = p.ws + WS_QF + (size_t)(head * NBLK32 + (tq0 >> 5)) * 3072 + lane * 16;
      q0 = *(const u32x4*)qp; q1 = *(const u32x4*)(qp + 1024); q2 = *(const u32x4*)(qp + 2048); }
    i32x8 Q01 = {(int)q0.x, (int)q0.y, (int)q0.z, (int)q0.w, (int)q1.x, (int)q1.y, (int)q1.z, (int)q1.w};
    i32x8 Q2Z = {(int)q2.x, (int)q2.y, (int)q2.z, (int)q2.w, 0, 0, 0, 0};
    asm volatile("" : "+v"(Q01), "+v"(Q2Z));
    i32x8 PP = {0, 0, 0, 0, 0, 0, 0, 0};
    f32x16 o0, o1, negm;
#pragma unroll
    for (int r = 0; r < 16; ++r) { o0[r] = 0.f; o1[r] = 0.f; negm[r] = 0.f; }
    AT_PIN(negm);
    float mref = 0.f, l0 = 0.f, l1 = 0.f;
    AT_WAIT_BAR(5);
    int slot = 0;
    for (int u = 0; u < NU; ++u) {
        const bool pf = u + 2 < NU;
        const int s2 = slot == 0 ? 2 : slot - 1;
#pragma unroll
        for (int g = 0; g < 2; ++g) {
            if (pf && (wid & 1) == g) attn_dma(lds0, s2, srdK, srdV, koff0 + (unsigned)(u + 2) * 24576u, voff0 + (unsigned)(u + 2) * 16384u, wid, lane);
            const unsigned char* kb = lds + slot * AT_STAGE + g * 12288 + lane * 16;
            const unsigned char* vb = lds + slot * AT_STAGE + 24576 + g * 8192 + lane * 16;
            f32x16 x0, x1, y0, y1;
            { const u32x4 a0 = *(const u32x4*)(kb), a1 = *(const u32x4*)(kb + 1024), a2 = *(const u32x4*)(kb + 2048);
              const u32x4 b0 = *(const u32x4*)(kb + 3072), b1 = *(const u32x4*)(kb + 4096), b2 = *(const u32x4*)(kb + 5120);
              i32x8 KA = {(int)a0.x, (int)a0.y, (int)a0.z, (int)a0.w, (int)a1.x, (int)a1.y, (int)a1.z, (int)a1.w};
              i32x8 KB = {(int)b0.x, (int)b0.y, (int)b0.z, (int)b0.w, (int)b1.x, (int)b1.y, (int)b1.z, (int)b1.w};
              x0 = mfma8v(KA, Q01, negm); x1 = mfma8v(KB, Q01, negm);
              KA[0] = (int)a2.x; KA[1] = (int)a2.y; KA[2] = (int)a2.z; KA[3] = (int)a2.w;
              KB[0] = (int)b2.x; KB[1] = (int)b2.y; KB[2] = (int)b2.z; KB[3] = (int)b2.w;
              x0 = mfma8v(KA, Q2Z, x0); x1 = mfma8v(KB, Q2Z, x1); }
            __builtin_amdgcn_sched_barrier(0);
            { const u32x4 c0 = *(const u32x4*)(kb + 6144), c1 = *(const u32x4*)(kb + 7168), c2 = *(const u32x4*)(kb + 8192);
              const u32x4 d0 = *(const u32x4*)(kb + 9216), d1 = *(const u32x4*)(kb + 10240), d2 = *(const u32x4*)(kb + 11264);
              i32x8 KC = {(int)c0.x, (int)c0.y, (int)c0.z, (int)c0.w, (int)c1.x, (int)c1.y, (int)c1.z, (int)c1.w};
              i32x8 KD = {(int)d0.x, (int)d0.y, (int)d0.z, (int)d0.w, (int)d1.x, (int)d1.y, (int)d1.z, (int)d1.w};
              y0 = mfma8v(KC, Q01, negm); y1 = mfma8v(KD, Q01, negm);
              KC[0] = (int)c2.x; KC[1] = (int)c2.y; KC[2] = (int)c2.z; KC[3] = (int)c2.w;
              KD[0] = (int)d2.x; KD[1] = (int)d2.y; KD[2] = (int)d2.z; KD[3] = (int)d2.w;
              y0 = mfma8v(KC, Q2Z, y0); y1 = mfma8v(KD, Q2Z, y1); }
            asm volatile("s_nop 15\n\ts_nop 15" : "+v"(x0), "+v"(x1), "+v"(y0), "+v"(y1));
            float ma = max3f(x0[0], x0[1], x1[0]), mb = max3f(x0[2], x0[3], x1[1]); ma = max3f(ma, x1[2], x1[3]);
            float mc = max3f(y0[0], y0[1], y1[0]), md = max3f(y0[2], y0[3], y1[1]); mc = max3f(mc, y1[2], y1[3]);
#pragma unroll
            for (int r = 4; r < 16; r += 4) {
                ma = max3f(ma, x0[r], x0[r + 1]); mb = max3f(mb, x0[r + 2], x0[r + 3]); mc = max3f(mc, y0[r], y0[r + 1]); md = max3f(md, y0[r + 2], y0[r + 3]);
                ma = max3f(ma, x1[r], x1[r + 1]); mb = max3f(mb, x1[r + 2], x1[r + 3]); mc = max3f(mc, y1[r], y1[r + 1]); md = max3f(md, y1[r + 2], y1[r + 3]);
            }
            float mx = max2f_pad(max3f(ma, mb, mc), md);
            { auto rr = __builtin_amdgcn_permlane32_swap(__float_as_uint(mx), __float_as_uint(mx), false, false); mx = fmaxf(__uint_as_float(rr[0]), __uint_as_float(rr[1])); }
            const bool first = (u == 0) && (g == 0);
            if (__builtin_expect(first || __any(mx > 7.5f), 0)) {
                const float d = first ? mx - 6.f : fmaxf(mx - 6.f, 0.f);
                mref += d;
                const float f = __builtin_amdgcn_exp2f(-d);
#pragma unroll
                for (int r = 0; r < 16; ++r) { x0[r] -= d; x1[r] -= d; y0[r] -= d; y1[r] -= d; o0[r] *= f; o1[r] *= f; negm[r] = -mref; }
                l0 *= f; l1 *= f;
                AT_PIN(negm);
            }
#pragma unroll
            for (int r = 0; r < 16; ++r) { x0[r] = __builtin_amdgcn_exp2f(x0[r]); x1[r] = __builtin_amdgcn_exp2f(x1[r]); }
#pragma unroll
            for (int r = 0; r < 16; ++r) { l0 += x0[r]; AT_PIN(l0); l1 += x1[r]; AT_PIN(l1); }
            pack32_fp8_into(PP, x0, x1);
            { const u32x4 v00 = *(const u32x4*)(vb), v01 = *(const u32x4*)(vb + 1024), v10 = *(const u32x4*)(vb + 2048), v11 = *(const u32x4*)(vb + 3072);
              const i32x8 V0 = {(int)v00.x, (int)v00.y, (int)v00.z, (int)v00.w, (int)v01.x, (int)v01.y, (int)v01.z, (int)v01.w};
              const i32x8 V1 = {(int)v10.x, (int)v10.y, (int)v10.z, (int)v10.w, (int)v11.x, (int)v11.y, (int)v11.z, (int)v11.w};
              o0 = mfma8v(V0, PP, o0); o1 = mfma8v(V1, PP, o1); }
#pragma unroll
            for (int r = 0; r < 16; ++r) { y0[r] = __builtin_amdgcn_exp2f(y0[r]); y1[r] = __builtin_amdgcn_exp2f(y1[r]); }
#pragma unroll
            for (int r = 0; r < 16; ++r) { l0 += y0[r]; AT_PIN(l0); l1 += y1[r]; AT_PIN(l1); }
            pack32_fp8_into(PP, y0, y1);
            { const u32x4 v00 = *(const u32x4*)(vb + 4096), v01 = *(const u32x4*)(vb + 5120), v10 = *(const u32x4*)(vb + 6144), v11 = *(const u32x4*)(vb + 7168);
              const i32x8 V0 = {(int)v00.x, (int)v00.y, (int)v00.z, (int)v00.w, (int)v01.x, (int)v01.y, (int)v01.z, (int)v01.w};
              const i32x8 V1 = {(int)v10.x, (int)v10.y, (int)v10.z, (int)v10.w, (int)v11.x, (int)v11.y, (int)v11.z, (int)v11.w};
              o0 = mfma8v(V0, PP, o0); o1 = mfma8v(V1, PP, o1); }
        }
        if (pf) AT_WAIT_BAR(5); else AT_WAIT_BAR(0);
        slot = slot == 2 ? 0 : slot + 1;
    }
    const float inv = 1.f / swap32_sum(l0 + l1);
    const int tok = tq0 + r32;
    const bf16_t* sz = (const bf16_t*)(p.ws + WS_SZ) + (size_t)tok * AW + head * 64 + 8 * hi;
    bf16_t* mo = (bf16_t*)(p.ws + WS_MIX2) + (size_t)tok * AW + head * 64 + 8 * hi;
#pragma unroll
    for (int d0 = 0; d0 < 2; ++d0)
#pragma unroll
        for (int q8 = 0; q8 < 2; ++q8) {
            const u32x4 g = *(const u32x4*)(sz + 32 * d0 + 16 * q8);
            float v[8];
#pragma unroll
            for (int e = 0; e < 4; ++e) {
                const float a = d0 == 0 ? o0[8 * q8 + 2 * e] : o1[8 * q8 + 2 * e], b = d0 == 0 ? o0[8 * q8 + 2 * e + 1] : o1[8 * q8 + 2 * e + 1];
                v[2 * e] = a * inv * bf_lo(g[e]); v[2 * e + 1] = b * inv * bf_hi(g[e]);
            }
            *(u32x4*)(mo + 32 * d0 + 16 * q8) = pack8(v);
        }
}


constexpr size_t WS_BAR = 640 * 1024;
#define XB_TMO      128
#define XB_XCNT(j)  (256  + 64 * (j))
#define XB_XSUB(j)  (1280 + 64 * (j))
#define XB_XGEN(j)  (2304 + 64 * (j))
#define XB_TOP      3328
#define XB_TOPGEN   3392
#define XCD_BAR_WORDS 3456
#define XB_SPIN_CAP (1u << 18)
__device__ __forceinline__ unsigned xb_ld(unsigned* p)              { return __hip_atomic_load(p, __ATOMIC_RELAXED, __HIP_MEMORY_SCOPE_AGENT); }
__device__ __forceinline__ unsigned xb_add(unsigned* p, unsigned v) { return __hip_atomic_fetch_add(p, v, __ATOMIC_RELAXED, __HIP_MEMORY_SCOPE_AGENT); }
__device__ __forceinline__ unsigned xb_xcc_id() { return (unsigned)__builtin_amdgcn_s_getreg((3 << 11) | 20) & 0xFu; }
#define XB_SPIN(cond, bar) do { unsigned _sp = 0; while (cond) { __builtin_amdgcn_s_sleep(1); \
    if ((++_sp & 255u) == 0u) { if (xb_ld(&(bar)[XB_TMO])) break; if (_sp > XB_SPIN_CAP) { atomicAdd(&(bar)[XB_TMO], 1u); break; } } } } while (0)
struct XcdBarrier { unsigned* bar; unsigned x; unsigned nloc, nx; };
__device__ __forceinline__ XcdBarrier xcd_barrier_post(unsigned* bar) {
    XcdBarrier b; b.bar = bar; b.x = xb_xcc_id(); b.nloc = 0u; b.nx = 0u;
    if (threadIdx.x == 0) (void)xb_add(&bar[XB_XCNT(b.x)], 1u);
    return b;
}
__device__ __forceinline__ void xcd_barrier_complete(unsigned* bar, unsigned x, unsigned& nloc, unsigned& nx) {
    const unsigned G = gridDim.x * gridDim.y * gridDim.z;
    unsigned sum, cnt, mine, sp = 0u;
    for (;;) {
        sum = 0u; cnt = 0u; mine = 0u;
#pragma unroll
        for (unsigned j = 0; j < 16; ++j) { const unsigned c = xb_ld(&bar[XB_XCNT(j)]); sum += c; cnt += (c > 0u) ? 1u : 0u; mine = (j == x) ? c : mine; }
        if (sum == G) break;
        __builtin_amdgcn_s_sleep(1);
        if ((++sp & 255u) == 0u) { if (xb_ld(&bar[XB_TMO])) break; if (sp > XB_SPIN_CAP) { atomicAdd(&bar[XB_TMO], 1u); break; } }
    }
    nloc = mine > 0u ? mine : 1u; nx = cnt > 0u ? cnt : 1u;
}
__device__ __forceinline__ void xcd_barrier(XcdBarrier& b) {
    asm volatile("s_waitcnt vmcnt(0)" ::: "memory");
    __syncthreads();
    if (threadIdx.x == 0) {
        unsigned* bar = b.bar;
        __builtin_amdgcn_s_waitcnt(0);
        unsigned nloc = b.nloc, nx = b.nx;
        if (nloc == 0u) { xcd_barrier_complete(bar, b.x, nloc, nx); b.nloc = nloc; b.nx = nx; }
        const unsigned old = xb_add(&bar[XB_XSUB(b.x)], 1u);
        const unsigned gen = old / nloc;
        if (old + 1u == (gen + 1u) * nloc) {
            __builtin_amdgcn_fence(__ATOMIC_RELEASE, "agent");
            asm volatile("s_waitcnt vmcnt(0)" ::: "memory");
            const unsigned og = xb_add(&bar[XB_TOP], 1u);
            const unsigned tg = og / nx;
            if (og + 1u == (tg + 1u) * nx) xb_add(&bar[XB_TOPGEN], 1u);
            else XB_SPIN(xb_ld(&bar[XB_TOPGEN]) == tg, bar);
            __builtin_amdgcn_fence(__ATOMIC_ACQUIRE, "agent");
            xb_add(&bar[XB_XGEN(b.x)], 1u);
            asm volatile("s_waitcnt vmcnt(0)" ::: "memory");
        } else {
            XB_SPIN(xb_ld(&bar[XB_XGEN(b.x)]) == gen, bar);
            __builtin_amdgcn_fence(__ATOMIC_ACQUIRE, "agent");
            asm volatile("s_waitcnt vmcnt(0)" ::: "memory");
        }
    }
    __syncthreads();
}

__global__ void __launch_bounds__(NTHR, 2) fwd_kernel(Params p) {
    extern __shared__ __attribute__((aligned(16))) unsigned char lds[];
    cg::grid_group grid = cg::this_grid();
    const int G = gridDim.x, bx = blockIdx.x, tid = threadIdx.x;
    const int gtid = bx * NTHR + tid, gthreads = G * NTHR;
    const int xcd = bx & 7, lb = bx >> 3, GX = G >> 3;
    unsigned char* ws = p.ws;

    __syncthreads();
    XcdBarrier xbar = xcd_barrier_post((unsigned*)(ws + WS_BAR));
    if (p.ws == nullptr) grid.sync();
    phase0(p, gtid, gthreads);
    xcd_barrier(xbar);

    { EpiIn E{ws}; const bf16_t* xn = (const bf16_t*)(ws + WS_XN); const bf16_t* W = (const bf16_t*)(ws + WS_WIN);
      gemm_dma<4, 2, 0>(lds, xn, xn, 1 << 30, DM, W, DM, 13, xcd, lb, GX, E); }
    xcd_barrier(xbar);

    { EpiQ E{ws}; const bf16_t* A = (const bf16_t*)(ws + WS_QLAT); const bf16_t* W = (const bf16_t*)(ws + WS_WUQ);
      gemm_dma<2, 3, 0>(lds, A, A, 1 << 30, QLR, W, QLR, 2, xcd, lb, GX, E); }
    { EpiKV E{ws}; const bf16_t* A = (const bf16_t*)(ws + WS_KVLAT); const bf16_t* W = (const bf16_t*)(ws + WS_WUKV);
      gemm_dma<4, 2, 1>(lds, A, A, 1 << 30, KVLR, W, KVLR, 4, xcd, lb, GX, E); }
    conv_phase(p, gtid, gthreads);
    xcd_barrier(xbar);

    for (int w = lb; w < 128; w += GX) { const int bl = w >> 6, qblk = w & 63; attn_unit(lds, p, xcd, NTOK_P + bl * SEQ_S, SEQ_S, qblk); }
    { unsigned* tick = (unsigned*)(ws + WS_BAR) + 3584 + 64 * xcd;
      for (;;) {
          if (tid == 0) *(volatile unsigned*)lds = xb_add(tick, 1u);
          __syncthreads();
          const unsigned w2 = *(volatile unsigned*)lds;
          __syncthreads();
          if (w2 >= 64u) break;
          attn_unit(lds, p, (int)(w2 >> 3), xcd * SEQ_P, SEQ_P, (int)(w2 & 7));
      } }
    xcd_barrier(xbar);

    { EpiOut E{ws}; const bf16_t* A0 = (const bf16_t*)(ws + WS_MIXA); const bf16_t* A1 = (const bf16_t*)(ws + WS_MIX2); const bf16_t* W = (const bf16_t*)(ws + WS_WOUT);
      gemm_dma<4, 2, 0>(lds, A0, A1, 512, CW, W, DM, 4, xcd, lb, GX, E); }
    xcd_barrier(xbar);

    { const float* ssq = (const float*)(ws + WS_SSQ) + 2 * NTOK; const bf16_t* ob = (const bf16_t*)(ws + WS_XN);
      const int lane = tid & 63, gw = gtid >> 6, nw = gthreads >> 6;
      f32x4 g[4];
#pragma unroll
      for (int j = 0; j < 4; ++j) g[j] = *(const f32x4*)(p.norm_post + 4 * lane + 256 * j);
      for (int row = gw * 2; row < NTOK; row += nw * 2) {
          f32x4 xv[2][4]; u32x2 ov[2][4]; float rs[2];
#pragma unroll
          for (int u = 0; u < 2; ++u) {
              const float* xr = xrow(p, row + u) + 4 * lane; const bf16_t* orow = ob + (size_t)(row + u) * DM + 4 * lane;
#pragma unroll
              for (int j = 0; j < 4; ++j) { xv[u][j] = __builtin_nontemporal_load((const f32x4*)(xr + 256 * j)); ov[u][j] = __builtin_nontemporal_load((const u32x2*)(orow + 256 * j)); }
              rs[u] = rsqrtf(ssq[row + u] * (1.f / DM) + EPS);
          }
#pragma unroll
          for (int u = 0; u < 2; ++u) {
              float* yr = p.out + (size_t)(row + u) * DM + 4 * lane;
#pragma unroll
              for (int j = 0; j < 4; ++j) {
                  f32x4 o; o.x = bf_lo(ov[u][j].x); o.y = bf_hi(ov[u][j].x); o.z = bf_lo(ov[u][j].y); o.w = bf_hi(ov[u][j].y);
                  __builtin_nontemporal_store(xv[u][j] + o * rs[u] * g[j], (f32x4*)(yr + 256 * j));
              }
          }
      } }
}

extern "C" void kernel_launch(void* const* d_in, const int* in_sizes, int n_in, void* d_out, int out_size, void* d_ws, size_t ws_size, hipStream_t stream) {
    static int grid_blocks = 0;
    if (!grid_blocks) {
        int dev = 0, cus = 0, per_cu = 0;
        hipGetDevice(&dev);
        hipDeviceGetAttribute(&cus, hipDeviceAttributeMultiprocessorCount, dev);
        hipFuncSetAttribute((const void*)fwd_kernel, hipFuncAttributeMaxDynamicSharedMemorySize, LDS_BYTES);
        hipOccupancyMaxActiveBlocksPerMultiprocessor(&per_cu, (const void*)fwd_kernel, NTHR, LDS_BYTES);
        if (per_cu < 1) per_cu = 1;
        if (per_cu > 1) per_cu = 1;
        grid_blocks = cus * per_cu;
        if (ws_size < WS_END) fprintf(stderr, "kernel_launch: workspace too small (%zu < %zu)\n", ws_size, (size_t)WS_END);
    }
    (void)hipMemsetAsync((unsigned char*)d_ws + WS_BAR, 0, 16384, stream);
    Params p{};
    p.x_prompt = (const float*)d_in[0]; p.x_sample = (const float*)d_in[1]; p.norm_pre = (const float*)d_in[2]; p.w_in = (const float*)d_in[3];
    p.conv_w = (const float*)d_in[4]; p.q_norm = (const float*)d_in[5]; p.w_uq = (const float*)d_in[6]; p.kv_norm = (const float*)d_in[7];
    p.w_ukv = (const float*)d_in[8]; p.w_out = (const float*)d_in[9]; p.norm_post = (const float*)d_in[10];
    p.out = (float*)d_out; p.ws = (unsigned char*)d_ws;
    void* args[] = {&p};
    hipError_t e = hipLaunchCooperativeKernel((const void*)fwd_kernel, dim3(grid_blocks), dim3(NTHR), args, LDS_BYTES, stream);
    if (e != hipSuccess) fprintf(stderr, "cooperative launch failed: %s (grid %d)\n", hipGetErrorString(e), grid_blocks);
}
```

```cpp
#include <hip/hip_runtime.h>
#include <hip/hip_cooperative_groups.h>
#include <cstdio>
#include <cstdint>
namespace cg = cooperative_groups;

typedef unsigned short bf16_t;
typedef short bf16x8 __attribute__((ext_vector_type(8)));
typedef float f32x16 __attribute__((ext_vector_type(16)));
typedef float f32x4 __attribute__((ext_vector_type(4)));
typedef float f32x2 __attribute__((ext_vector_type(2)));
typedef unsigned u32x4 __attribute__((ext_vector_type(4)));
typedef unsigned u32x2 __attribute__((ext_vector_type(2)));
#define LAS __attribute__((address_space(3)))

constexpr int DM = 1024, NTOK = 49152, NTOK_P = 16384, SEQ_P = 2048, SEQ_S = 16384;
constexpr int CW = 512, NH = 8, QLR = 384, KVLR = 256, ROPE = 32, AW = 512;
constexpr int NIN = 3328;
constexpr int NBLK32 = NTOK / 32;
constexpr float EPS = 1e-6f;
constexpr float C2 = 0.14724444f;

constexpr size_t MiB = 1u << 20;
constexpr size_t WS_SSQ = 0;
constexpr size_t WS_COS = 1 * MiB, WS_SIN = 2 * MiB;
constexpr size_t WS_WIN = 3 * MiB;
constexpr size_t WS_WUQ = 10 * MiB;
constexpr size_t WS_WUKV = 11 * MiB;
constexpr size_t WS_WOUT = 12 * MiB;
constexpr size_t WS_XN = 16 * MiB;
constexpr size_t WS_QF = 16 * MiB;
constexpr size_t WS_CU = 112 * MiB;
constexpr size_t WS_GZ = 160 * MiB;
constexpr size_t WS_SZ = 208 * MiB;
constexpr size_t WS_QLAT = 256 * MiB;
constexpr size_t WS_KVLAT = 292 * MiB;
constexpr size_t WS_MIX2 = 256 * MiB;
constexpr size_t WS_KF = 316 * MiB;
constexpr size_t WS_VF = 388 * MiB;
constexpr size_t WS_MIXA = 436 * MiB;
constexpr size_t WS_END = 484 * MiB;

constexpr int LDS_BYTES = 131072;
constexpr int NTHR = 512;

struct Params {
    const float* x_prompt; const float* x_sample; const float* norm_pre; const float* w_in; const float* conv_w;
    const float* q_norm; const float* w_uq; const float* kv_norm; const float* w_ukv; const float* w_out; const float* norm_post;
    float* out; unsigned char* ws;
};

__device__ __forceinline__ unsigned pk_bf16(float lo, float hi) {
    typedef __bf16 b2 __attribute__((ext_vector_type(2)));
    f32x2 v = {lo, hi}; b2 b = __builtin_convertvector(v, b2); return __builtin_bit_cast(unsigned, b);
}
__device__ __forceinline__ float bf_lo(unsigned u) { return __uint_as_float(u << 16); }
__device__ __forceinline__ float bf_hi(unsigned u) { return __uint_as_float(u & 0xffff0000u); }
__device__ __forceinline__ u32x4 pack8(const float* v) {
    u32x4 w; w.x = pk_bf16(v[0], v[1]); w.y = pk_bf16(v[2], v[3]); w.z = pk_bf16(v[4], v[5]); w.w = pk_bf16(v[6], v[7]); return w;
}
typedef int i32x8 __attribute__((ext_vector_type(8)));
__device__ __forceinline__ u32x4 pack16_fp8(const float* v) {
    u32x4 w;
#pragma unroll
    for (int k = 0; k < 4; ++k) { int t = __builtin_amdgcn_cvt_pk_fp8_f32(v[4 * k], v[4 * k + 1], 0, false); t = __builtin_amdgcn_cvt_pk_fp8_f32(v[4 * k + 2], v[4 * k + 3], t, true); w[k] = (unsigned)t; }
    return w;
}
__device__ __forceinline__ f32x16 mfma8(u32x4 a0, u32x4 a1, u32x4 b0, u32x4 b1, f32x16 c) {
    const i32x8 A = {(int)a0.x, (int)a0.y, (int)a0.z, (int)a0.w, (int)a1.x, (int)a1.y, (int)a1.z, (int)a1.w};
    const i32x8 B = {(int)b0.x, (int)b0.y, (int)b0.z, (int)b0.w, (int)b1.x, (int)b1.y, (int)b1.z, (int)b1.w};
    return __builtin_amdgcn_mfma_scale_f32_32x32x64_f8f6f4(A, B, c, 0, 0, 0, 0x7f7f7f7f, 0, 0x7f7f7f7f);
}
__device__ __forceinline__ f32x16 mfma8v(i32x8 A, i32x8 B, f32x16 c) { return __builtin_amdgcn_mfma_scale_f32_32x32x64_f8f6f4(A, B, c, 0, 0, 0, 0x7f7f7f7f, 0, 0x7f7f7f7f); }
__device__ __forceinline__ void pack32_fp8_into(i32x8& P, const f32x16& s0, const f32x16& s1) {
#pragma unroll
    for (int k = 0; k < 4; ++k) { int t = __builtin_amdgcn_cvt_pk_fp8_f32(s0[4 * k], s0[4 * k + 1], P[k], false); P[k] = __builtin_amdgcn_cvt_pk_fp8_f32(s0[4 * k + 2], s0[4 * k + 3], t, true); }
#pragma unroll
    for (int k = 0; k < 4; ++k) { int t = __builtin_amdgcn_cvt_pk_fp8_f32(s1[4 * k], s1[4 * k + 1], P[4 + k], false); P[4 + k] = __builtin_amdgcn_cvt_pk_fp8_f32(s1[4 * k + 2], s1[4 * k + 3], t, true); }
}
__device__ __forceinline__ float silu_f(float z) { return z / (1.f + __expf(-z)); }
__device__ __forceinline__ int cperm(int p) { const int hp = (p >> 2) & 1, r = (p & 3) + 4 * (p >> 3); return 16 * (r >> 3) + 8 * hp + (r & 7); }
__device__ __forceinline__ int crow(int r, int hi) { return (r & 3) + 8 * (r >> 2) + 4 * hi; }
__device__ __forceinline__ float swap32_max(float m) {
    auto rr = __builtin_amdgcn_permlane32_swap(__float_as_uint(m), __float_as_uint(m), false, false);
    return fmaxf(__uint_as_float(rr[0]), __uint_as_float(rr[1]));
}
__device__ __forceinline__ float swap32_sum(float m) {
    auto rr = __builtin_amdgcn_permlane32_swap(__float_as_uint(m), __float_as_uint(m), false, false);
    return __uint_as_float(rr[0]) + __uint_as_float(rr[1]);
}
__device__ __forceinline__ float wave_sum(float v) {
#pragma unroll
    for (int o = 1; o < 64; o <<= 1) v += __shfl_xor(v, o);
    return v;
}
__device__ __forceinline__ const float* xrow(const Params& p, int tok) {
    return tok < NTOK_P ? p.x_prompt + (size_t)tok * DM : p.x_sample + (size_t)(tok - NTOK_P) * DM;
}
__device__ __forceinline__ int tok_pos(int tok) { return tok < NTOK_P ? (tok & (SEQ_P - 1)) : (tok & (SEQ_S - 1)); }

__device__ __forceinline__ void glds16(const void* gsrc, unsigned lds_dst) {
    unsigned keep;
    asm volatile("s_mov_b32 %0, m0\n\ts_mov_b32 m0, %2\n\ts_nop 0\n\tglobal_load_lds_dwordx4 %1, off\n\ts_mov_b32 m0, %0" : "=&s"(keep) : "v"(gsrc), "s"(lds_dst) : "memory");
}
#define AT_WAIT_BAR(N) asm volatile("s_waitcnt vmcnt(" #N ") lgkmcnt(0)\n\ts_barrier" ::: "memory")
typedef __amdgpu_buffer_rsrc_t srd_t;
__device__ __forceinline__ srd_t make_srd(const void* base) { return __builtin_amdgcn_make_buffer_rsrc((void*)base, (short)0, 0x7ffffffe, 0x00020000); }
__device__ __forceinline__ void bdma16(unsigned m0v, unsigned voff, srd_t srd, unsigned soff) {
    asm volatile("s_nop 4\n\ts_mov_b32 m0, %0\n\ts_nop 0\n\tbuffer_load_dwordx4 %1, %2, %3 offen lds" :: "s"(m0v), "v"(voff), "s"(srd), "s"(soff) : "m0", "memory");
}
__device__ __forceinline__ unsigned rflu(unsigned v) { return (unsigned)__builtin_amdgcn_readfirstlane((int)v); }

__device__ __forceinline__ int win_src(int np) {
    const int T = np >> 7, w = np & 127;
    if (T < 16) { const int wn = w >> 6, j = (w >> 5) & 1, q = (w >> 4) & 1, i16 = w & 15; return (2 * j + q) * 512 + 32 * T + 16 * wn + i16; }
    if (T < 21) return np;
    if (T < 25) return 2720 + (np - 2688);
    return w < 32 ? 2688 + w : -1;
}
template <int MODE>
__device__ __forceinline__ void prep_weight(const float* __restrict__ w, const float* __restrict__ gain, bf16_t* WT, int K, int Nsrc, int Ndst, int gtid, int gthreads) {
    const int items = Ndst * (K / 8);
    for (int id = gtid; id < items; id += gthreads) {
        const int n = id % Ndst, kc = id / Ndst, k0 = kc * 8;
        const int src = (MODE == 1) ? win_src(n) : n;
        float v[8];
#pragma unroll
        for (int e = 0; e < 8; ++e) v[e] = (src >= 0) ? w[(size_t)(k0 + e) * Nsrc + src] * (gain ? gain[k0 + e] : 1.f) : 0.f;
        *(u32x4*)(WT + (size_t)n * K + k0) = pack8(v);
    }
}
__device__ __forceinline__ void rope_entry(int pos, int i, float& c, float& s) {
    const int a = i & 3, b = i >> 2;
    double base = a == 0 ? 1.0 : a == 1 ? 0.5623413251903491 : a == 2 ? 0.31622776601683794 : 0.1778279410038923;
    double sc = b == 0 ? 1.0 : b == 1 ? 0.1 : b == 2 ? 0.01 : 0.001;
    const float freq = (float)(base * sc);
    const float angf = (float)pos * freq;
    const double x = (double)angf;
    const double kq = rint(x * 0.6366197723675814);
    const double r = (x - kq * 1.5707963267948966) - kq * 6.123233995736766e-17;
    const double r2 = r * r;
    const double sn = r * (1.0 + r2 * (-1.0 / 6 + r2 * (1.0 / 120 + r2 * (-1.0 / 5040 + r2 * (1.0 / 362880 + r2 * (-1.0 / 39916800))))));
    const double cs = 1.0 + r2 * (-0.5 + r2 * (1.0 / 24 + r2 * (-1.0 / 720 + r2 * (1.0 / 40320 + r2 * (-1.0 / 3628800 + r2 * (1.0 / 479001600))))));
    const int qd = ((int)kq) & 3;
    const double so = qd == 0 ? sn : qd == 1 ? cs : qd == 2 ? -sn : -cs;
    const double co = qd == 0 ? cs : qd == 1 ? -sn : qd == 2 ? -cs : sn;
    c = (float)co; s = (float)so;
}
__device__ __forceinline__ void phase0(const Params& p, int gtid, int gthreads) {
    unsigned char* ws = p.ws;
    float* ssq = (float*)(ws + WS_SSQ);
    for (int i = gtid; i < 3 * NTOK; i += gthreads) ssq[i] = 0.f;
    float* ct = (float*)(ws + WS_COS); float* st = (float*)(ws + WS_SIN);
    for (int i = gtid; i < SEQ_S * 16; i += gthreads) { float c, s; rope_entry(i >> 4, i & 15, c, s); ct[i] = c; st[i] = s; }
    prep_weight<1>(p.w_in, p.norm_pre, (bf16_t*)(ws + WS_WIN), DM, 3232, NIN, gtid, gthreads);
    prep_weight<0>(p.w_uq, p.q_norm, (bf16_t*)(ws + WS_WUQ), QLR, 768, 768, gtid, gthreads);
    prep_weight<0>(p.w_ukv, p.kv_norm, (bf16_t*)(ws + WS_WUKV), KVLR, 1024, 1024, gtid, gthreads);
    prep_weight<0>(p.w_out, nullptr, (bf16_t*)(ws + WS_WOUT), DM, 1024, 1024, gtid, gthreads);
    const int gw = gtid >> 6, nw = gthreads >> 6, lane = threadIdx.x & 63;
    bf16_t* xn = (bf16_t*)(ws + WS_XN);
    for (int row = gw * 2; row < NTOK; row += nw * 2) {
        f32x4 v[2][4]; float s[2];
#pragma unroll
        for (int u = 0; u < 2; ++u) {
            const f32x4* xr = (const f32x4*)xrow(p, row + u) + lane; s[u] = 0.f;
#pragma unroll
            for (int j = 0; j < 4; ++j) { v[u][j] = __builtin_nontemporal_load(xr + 64 * j); }
        }
#pragma unroll
        for (int u = 0; u < 2; ++u) {
#pragma unroll
            for (int j = 0; j < 4; ++j) s[u] += (v[u][j].x * v[u][j].x + v[u][j].y * v[u][j].y) + (v[u][j].z * v[u][j].z + v[u][j].w * v[u][j].w);
            const float rs = rsqrtf(wave_sum(s[u]) * (1.f / DM) + EPS);
            u32x2* o = (u32x2*)(xn + (size_t)(row + u) * DM) + lane;
#pragma unroll
            for (int j = 0; j < 4; ++j) { u32x2 w; w.x = pk_bf16(v[u][j].x * rs, v[u][j].y * rs); w.y = pk_bf16(v[u][j].z * rs, v[u][j].w * rs); o[64 * j] = w; }
        }
    }
}

__device__ __forceinline__ void tile_map(int w, int NT, int xcd, int MPX, int& mt, int& nt) {
    const int g = w / (8 * NT), rem = w % (8 * NT);
    nt = rem >> 3; mt = xcd * MPX + g * 8 + (rem & 7);
}
template <int MI, int NJ, int MODE, class Epi>
__device__ __forceinline__ void gemm_dma(unsigned char* lds, const bf16_t* __restrict__ A0, const bf16_t* __restrict__ A1, int ksplit, int lda,
                                         const bf16_t* __restrict__ Bt, int K, int NT, int xcd, int lb, int GX, const Epi& epi) {
    constexpr int NSA = 4 * MI, NSUB = 4 * MI + 8 * NJ, STAGE = NSUB * 1024, NIT = NSUB / 8, NITA = NSA / 8, BOFF = NSA * 1024, MPX = 96 / MI;
    static_assert(4 * STAGE <= LDS_BYTES && NSUB % 8 == 0 && NSA % 8 == 0, "lds");
    const int tid = threadIdx.x, lane = tid & 63, wid = __builtin_amdgcn_readfirstlane(tid >> 6), wm = wid >> 2, wn = wid & 3;
    const int r32 = lane & 31, hi = lane >> 5;
    const unsigned lds0 = rflu((unsigned)(uintptr_t)lds);
    const int nk = K / 32, count = MPX * NT;
    int w = lb;
    if (w >= count) return;
    int mt, nt; tile_map(w, NT, xcd, MPX, mt, nt);
    const int rowl = lane >> 2, colsw = 8 * ((lane & 3) ^ ((lane >> 4) & 3));
    const unsigned voffA = (unsigned)((rowl * lda + colsw) * 2), voffB = (unsigned)((rowl * K + colsw) * 2);
    const srd_t srdA0 = make_srd(A0), srdA1 = make_srd(A1), srdB = make_srd(Bt);
    auto dma = [&](int tmt, int tnt, int kt, int stage) {
        const int k0 = kt * 32;
        const bool lo = k0 < ksplit;
        const unsigned sa = (unsigned)(tmt * 64 * MI) * (unsigned)(lda * 2) + (unsigned)((lo ? k0 : k0 - ksplit) * 2);
        const unsigned sbb = (unsigned)(tnt * 128 * NJ) * (unsigned)(K * 2) + (unsigned)(k0 * 2);
#pragma unroll
        for (int it = 0; it < NIT; ++it) {
            const int f = wid + 8 * it;
            const unsigned m0v = rflu(lds0 + (unsigned)(stage * STAGE + f * 1024));
            if (it < NITA) { const unsigned so = rflu(sa + (unsigned)(f * 16) * (unsigned)(lda * 2)); if (lo) bdma16(m0v, voffA, srdA0, so); else bdma16(m0v, voffA, srdA1, so); }
            else { const unsigned so = rflu(sbb + (unsigned)((f - NSA) * 16) * (unsigned)(K * 2)); bdma16(m0v, voffB, srdB, so); }
        }
    };
    const int cb = cperm(r32);
    const int arow = (wm * 32 * MI + r32), brow = (wn * 32 * NJ + cb);
    const int abase = (arow >> 4) * 1024 + (arow & 15) * 64, ax = (arow >> 2) & 3;
    const int bbase = BOFF + (brow >> 4) * 1024 + (brow & 15) * 64, bx_ = (brow >> 2) & 3;
    const bool swp = (MODE == 0) || ((wn & 1) == 0);
    f32x16 acc[MI][NJ];
    auto compute = [&](int stage) {
        const unsigned char* base = lds + stage * STAGE;
#pragma unroll
        for (int kk = 0; kk < 2; ++kk) {
            bf16x8 af[MI], bfr[NJ];
            const int ca = ((2 * kk + hi) ^ ax) << 4, cbb = ((2 * kk + hi) ^ bx_) << 4;
#pragma unroll
            for (int i = 0; i < MI; ++i) af[i] = *(const bf16x8*)(base + abase + i * 2048 + ca);
#pragma unroll
            for (int j = 0; j < NJ; ++j) bfr[j] = *(const bf16x8*)(base + bbase + j * 2048 + cbb);
#pragma unroll
            for (int i = 0; i < MI; ++i)
#pragma unroll
                for (int j = 0; j < NJ; ++j) {
                    if (MODE == 0) acc[i][j] = __builtin_amdgcn_mfma_f32_32x32x16_bf16(bfr[j], af[i], acc[i][j], 0, 0, 0);
                    else { const bf16x8 xa = swp ? bfr[j] : af[i], xb = swp ? af[i] : bfr[j]; acc[i][j] = __builtin_amdgcn_mfma_f32_32x32x16_bf16(xa, xb, acc[i][j], 0, 0, 0); }
                }
        }
    };
    auto dma2 = [&](int tmt, int tnt, int kt2, int sb) { dma(tmt, tnt, 2 * kt2, 2 * sb); dma(tmt, tnt, 2 * kt2 + 1, 2 * sb + 1); };
    dma2(mt, nt, 0, 0);
    int sb = 0;
    const int nk2 = nk >> 1;
    for (;;) {
        const int wnx = w + GX; const bool has_next = wnx < count;
        int mt2 = mt, nt2 = nt; if (has_next) tile_map(wnx, NT, xcd, MPX, mt2, nt2);
#pragma unroll
        for (int i = 0; i < MI; ++i)
#pragma unroll
            for (int j = 0; j < NJ; ++j)
#pragma unroll
                for (int r = 0; r < 16; ++r) acc[i][j][r] = 0.f;
        AT_WAIT_BAR(0);
        for (int kt2 = 0; kt2 < nk2; ++kt2) {
            const bool last = kt2 + 1 == nk2;
            if (wm == 0) { if (!last) dma2(mt, nt, kt2 + 1, sb ^ 1); else if (has_next) dma2(mt2, nt2, 0, sb ^ 1); }
            compute(2 * sb);
            if (wm != 0) { if (!last) dma2(mt, nt, kt2 + 1, sb ^ 1); else if (has_next) dma2(mt2, nt2, 0, sb ^ 1); }
            compute(2 * sb + 1);
            if (!last) AT_WAIT_BAR(0);
            sb ^= 1;
        }
        epi(acc, mt, nt * 2 + (wn >> 1), wm, wn & 1, r32, hi);
        if (!has_next) break;
        w = wnx; mt = mt2; nt = nt2;
    }
    AT_WAIT_BAR(0);
}

struct EpiIn {
    unsigned char* ws;
    template <int MI> __device__ __forceinline__ void operator()(f32x16 (&acc)[MI][2], int mt, int nt, int wm, int wn, int r32, int hi) const {
        const int lane = r32 + 32 * hi;
        if (nt < 16) {
            bf16_t* cu = (bf16_t*)(ws + WS_CU); bf16_t* gz = (bf16_t*)(ws + WS_GZ);
#pragma unroll
            for (int i = 0; i < MI; ++i) {
                const int tok = mt * (64 * MI) + wm * (32 * MI) + 32 * i + r32; const int ch0 = 32 * nt + 16 * wn + 8 * hi;
                float a[8], b[8];
#pragma unroll
                for (int e = 0; e < 8; ++e) { const float u = acc[i][0][e], B = acc[i][0][8 + e], C = acc[i][1][e], z = acc[i][1][8 + e]; a[e] = C * u; b[e] = B * silu_f(z); }
                *(u32x4*)(cu + (size_t)tok * CW + ch0) = pack8(a);
                *(u32x4*)(gz + (size_t)tok * CW + ch0) = pack8(b);
            }
        } else if (nt < 21) {
            const bool isq = nt < 19;
            bf16_t* dst = (bf16_t*)(ws + (isq ? WS_QLAT : WS_KVLAT)); const int ld = isq ? QLR : KVLR; const int cb = (isq ? (nt - 16) : (nt - 19)) * 128 + wn * 64 + 8 * hi;
            float* ssq = (float*)(ws + WS_SSQ) + (isq ? 0 : NTOK);
#pragma unroll
            for (int i = 0; i < MI; ++i) {
                const int tok = mt * (64 * MI) + wm * (32 * MI) + 32 * i + r32; float ss = 0.f;
#pragma unroll
                for (int j = 0; j < 2; ++j)
#pragma unroll
                    for (int q = 0; q < 2; ++q) {
                        float v[8];
#pragma unroll
                        for (int e = 0; e < 8; ++e) { v[e] = acc[i][j][8 * q + e]; ss += v[e] * v[e]; }
                        *(u32x4*)(dst + (size_t)tok * ld + cb + 32 * j + 16 * q) = pack8(v);
                    }
                ss = swap32_sum(ss);
                if (hi == 0) atomicAdd(ssq + tok, ss);
            }
        } else if (nt < 25) {
            bf16_t* sz = (bf16_t*)(ws + WS_SZ); const int cb = (nt - 21) * 128 + wn * 64 + 8 * hi;
#pragma unroll
            for (int i = 0; i < MI; ++i) {
                const int tok = mt * (64 * MI) + wm * (32 * MI) + 32 * i + r32;
#pragma unroll
                for (int j = 0; j < 2; ++j)
#pragma unroll
                    for (int q = 0; q < 2; ++q) {
                        float v[8];
#pragma unroll
                        for (int e = 0; e < 8; ++e) v[e] = silu_f(acc[i][j][8 * q + e]);
                        *(u32x4*)(sz + (size_t)tok * AW + cb + 32 * j + 16 * q) = pack8(v);
                    }
            }
        } else if (wn == 0) {
            const float* ct = (const float*)(ws + WS_COS); const float* st = (const float*)(ws + WS_SIN);
            unsigned char* kf = ws + WS_KF;
#pragma unroll
            for (int i = 0; i < MI; ++i) {
                const int tok = mt * (64 * MI) + wm * (32 * MI) + 32 * i + r32; const int pos = tok_pos(tok);
                const f32x4 c0 = *(const f32x4*)(ct + pos * 16 + 8 * hi), c1 = *(const f32x4*)(ct + pos * 16 + 8 * hi + 4);
                const f32x4 s0 = *(const f32x4*)(st + pos * 16 + 8 * hi), s1 = *(const f32x4*)(st + pos * 16 + 8 * hi + 4);
                float o[16];
#pragma unroll
                for (int e = 0; e < 8; ++e) { const float c = e < 4 ? c0[e & 3] : c1[e & 3], s = e < 4 ? s0[e & 3] : s1[e & 3]; const float x1 = acc[i][0][e], x2 = acc[i][0][8 + e]; o[e] = x1 * c - x2 * s; o[8 + e] = x2 * c + x1 * s; }
                const u32x4 w1 = pack16_fp8(o); const int blk = tok >> 5;
#pragma unroll
                for (int h = 0; h < NH; ++h) *(u32x4*)(kf + ((size_t)(h * NBLK32 + blk) * 3 + 2) * 1024 + lane * 16) = w1;
            }
        }
    }
};
struct EpiQ {
    unsigned char* ws;
    template <int MI> __device__ __forceinline__ void operator()(f32x16 (&acc)[MI][3], int mt, int nt, int wm, int wn, int r32, int hi) const {
        const int lane = r32 + 32 * hi, head = nt * 2 + wn;
        const float* ssq = (const float*)(ws + WS_SSQ);
        const float* ct = (const float*)(ws + WS_COS); const float* st = (const float*)(ws + WS_SIN);
#pragma unroll
        for (int i = 0; i < MI; ++i) {
            const int tok = mt * (64 * MI) + wm * (32 * MI) + 32 * i + r32; const int pos = tok_pos(tok);
            const float rs = rsqrtf(__hip_atomic_load(ssq + tok, __ATOMIC_RELAXED, __HIP_MEMORY_SCOPE_AGENT) * (1.f / QLR) + EPS) * C2;
            unsigned char* d = ws + WS_QF + ((size_t)(head * NBLK32 + (tok >> 5)) * 3) * 1024 + lane * 16;
#pragma unroll
            for (int j = 0; j < 2; ++j) {
                float v[16];
#pragma unroll
                for (int r = 0; r < 16; ++r) v[r] = acc[i][j][r] * rs;
                *(u32x4*)(d + j * 1024) = pack16_fp8(v);
            }
            const f32x4 c0 = *(const f32x4*)(ct + pos * 16 + 8 * hi), c1 = *(const f32x4*)(ct + pos * 16 + 8 * hi + 4);
            const f32x4 s0 = *(const f32x4*)(st + pos * 16 + 8 * hi), s1 = *(const f32x4*)(st + pos * 16 + 8 * hi + 4);
            float o[16];
#pragma unroll
            for (int e = 0; e < 8; ++e) { const float c = e < 4 ? c0[e & 3] : c1[e & 3], s = e < 4 ? s0[e & 3] : s1[e & 3]; const float x1 = acc[i][2][e] * rs, x2 = acc[i][2][8 + e] * rs; o[e] = x1 * c - x2 * s; o[8 + e] = x2 * c + x1 * s; }
            *(u32x4*)(d + 2 * 1024) = pack16_fp8(o);
        }
    }
};
struct EpiKV {
    unsigned char* ws;
    template <int MI> __device__ __forceinline__ void operator()(f32x16 (&acc)[MI][2], int mt, int nt, int wm, int wn, int r32, int hi) const {
        static_assert(MI % 2 == 0, "V fragments pair two 32-token blocks");
        const int lane = r32 + 32 * hi, head = nt;
        const float* ssq = (const float*)(ws + WS_SSQ) + NTOK;
        if (wn == 0) {
#pragma unroll
            for (int i = 0; i < MI; ++i) {
                const int tok = mt * (64 * MI) + wm * (32 * MI) + 32 * i + r32;
                const float rs = rsqrtf(__hip_atomic_load(ssq + tok, __ATOMIC_RELAXED, __HIP_MEMORY_SCOPE_AGENT) * (1.f / KVLR) + EPS);
                unsigned char* d = ws + WS_KF + ((size_t)(head * NBLK32 + (tok >> 5)) * 3) * 1024 + lane * 16;
#pragma unroll
                for (int j = 0; j < 2; ++j) {
                    float v[16];
#pragma unroll
                    for (int r = 0; r < 16; ++r) v[r] = acc[i][j][r] * rs;
                    *(u32x4*)(d + j * 1024) = pack16_fp8(v);
                }
            }
        } else {
#pragma unroll
            for (int i = 0; i < MI; ++i) {
                const int tb = mt * (64 * MI) + wm * (32 * MI) + 32 * i;
                float rs[16];
#pragma unroll
                for (int r = 0; r < 16; ++r) rs[r] = rsqrtf(__hip_atomic_load(ssq + tb + crow(r, hi), __ATOMIC_RELAXED, __HIP_MEMORY_SCOPE_AGENT) * (1.f / KVLR) + EPS);
                unsigned char* d = ws + WS_VF + ((size_t)(head * (NTOK / 64) + (tb >> 6)) * 4) * 1024 + (i & 1) * 1024 + lane * 16;
#pragma unroll
                for (int j = 0; j < 2; ++j) {
                    float v[16];
#pragma unroll
                    for (int r = 0; r < 16; ++r) v[r] = acc[i][j][r] * rs[r];
                    *(u32x4*)(d + j * 2048) = pack16_fp8(v);
                }
            }
        }
    }
};
struct EpiOut {
    unsigned char* ws;
    template <int MI> __device__ __forceinline__ void operator()(f32x16 (&acc)[MI][2], int mt, int nt, int wm, int wn, int r32, int hi) const {
        float* ssq = (float*)(ws + WS_SSQ) + 2 * NTOK;
        bf16_t* ob = (bf16_t*)(ws + WS_XN);
#pragma unroll
        for (int i = 0; i < MI; ++i) {
            const int tok = mt * (64 * MI) + wm * (32 * MI) + 32 * i + r32; float ss = 0.f;
            bf16_t* d = ob + (size_t)tok * DM + nt * 128 + wn * 64 + 8 * hi;
#pragma unroll
            for (int j = 0; j < 2; ++j)
#pragma unroll
                for (int q = 0; q < 2; ++q) {
                    float v[8];
#pragma unroll
                    for (int e = 0; e < 8; ++e) { v[e] = acc[i][j][8 * q + e]; ss += v[e] * v[e]; }
                    *(u32x4*)(d + 32 * j + 16 * q) = pack8(v);
                }
            ss = swap32_sum(ss);
            if (hi == 0) atomicAdd(ssq + tok, ss);
        }
    }
};

__device__ __forceinline__ void conv_phase(const Params& p, int gtid, int gthreads) {
    const bf16_t* cu = (const bf16_t*)(p.ws + WS_CU); const bf16_t* gz = (const bf16_t*)(p.ws + WS_GZ); bf16_t* mixa = (bf16_t*)(p.ws + WS_MIXA);
    for (int id = gtid; id < NTOK * 64; id += gthreads) {
        const int tok = id >> 6, c0 = (id & 63) * 8, pos = tok_pos(tok), S = tok < NTOK_P ? SEQ_P : SEQ_S;
        const u32x4 z4 = {0u, 0u, 0u, 0u};
        const u32x4 cm = *(const u32x4*)(cu + (size_t)tok * CW + c0);
        const u32x4 cl = pos > 0 ? *(const u32x4*)(cu + (size_t)(tok - 1) * CW + c0) : z4;
        const u32x4 cr = pos < S - 1 ? *(const u32x4*)(cu + (size_t)(tok + 1) * CW + c0) : z4;
        const u32x4 g = *(const u32x4*)(gz + (size_t)tok * CW + c0);
        float w0[8], w1[8], w2[8], o[8];
#pragma unroll
        for (int e = 0; e < 8; ++e) { w0[e] = p.conv_w[c0 + e]; w1[e] = p.conv_w[CW + c0 + e]; w2[e] = p.conv_w[2 * CW + c0 + e]; }
#pragma unroll
        for (int e = 0; e < 4; ++e) {
            o[2 * e] = bf_lo(g[e]) * (w0[2 * e] * bf_lo(cl[e]) + w1[2 * e] * bf_lo(cm[e]) + w2[2 * e] * bf_lo(cr[e]));
            o[2 * e + 1] = bf_hi(g[e]) * (w0[2 * e + 1] * bf_hi(cl[e]) + w1[2 * e + 1] * bf_hi(cm[e]) + w2[2 * e + 1] * bf_hi(cr[e]));
        }
        *(u32x4*)(mixa + (size_t)tok * CW + c0) = pack8(o);
    }
}

constexpr int AT_STAGE = 40960, AT_NSLOT = 3;
static_assert(AT_NSLOT * AT_STAGE <= LDS_BYTES, "attention ring");
__device__ __forceinline__ float max3f(float a, float b, float c) { float r; asm("v_max3_f32 %0, %1, %2, %3" : "=v"(r) : "v"(a), "v"(b), "v"(c)); return r; }
__device__ __forceinline__ float max2f_pad(float a, float b) { float r; asm("v_max_f32_e32 %0, %1, %2\n\ts_nop 1" : "=v"(r) : "v"(a), "v"(b)); return r; }
#define AT_PIN(x) asm volatile("" : "+v"(x))
__device__ __forceinline__ void attn_dma(unsigned lds0, int slot, srd_t srdK, srd_t srdV, unsigned koff, unsigned voffs, int wid, int lane) {
#pragma unroll
    for (int it = 0; it < 5; ++it) {
        const int pc = wid + 8 * it;
        const unsigned m0v = rflu(lds0 + (unsigned)(slot * AT_STAGE + pc * 1024));
        if (it < 3) bdma16(m0v, (unsigned)lane * 16u, srdK, rflu(koff + (unsigned)pc * 1024u));
        else bdma16(m0v, (unsigned)lane * 16u, srdV, rflu(voffs + (unsigned)(pc - 24) * 1024u));
    }
}
__device__ __forceinline__ void attn_unit(unsigned char* lds, const Params& p, int head, int tok0, int S, int qblk) {
    const int tid = threadIdx.x, lane = tid & 63, wid = __builtin_amdgcn_readfirstlane(tid >> 6), r32 = lane & 31, hi = lane >> 5;
    const unsigned lds0 = rflu((unsigned)(uintptr_t)lds);
    const int tq0 = tok0 + qblk * 256 + wid * 32;
    const srd_t srdK = make_srd(p.ws + WS_KF), srdV = make_srd(p.ws + WS_VF);
    const unsigned koff0 = (unsigned)(head * NBLK32 + (tok0 >> 5)) * 3072u;
    const unsigned voff0 = (unsigned)(head * (NTOK / 64) + (tok0 >> 6)) * 4096u;
    const int NU = S / 256;
    attn_dma(lds0, 0, srdK, srdV, koff0, voff0, wid, lane);
    attn_dma(lds0, 1, srdK, srdV, koff0 + 24576u, voff0 + 16384u, wid, lane);
    u32x4 q0, q1, q2;
    { const unsigned char* qp = p.ws + WS_QF + (size_t)(head * NBLK32 + (tq0 >> 5)) * 3072 + lane * 16;
      q0 = *(const u32x4*)qp; q1 = *(const u32x4*)(qp + 1024); q2 = *(const u32x4*)(qp + 2048); }
    i32x8 Q01 = {(int)q0.x, (int)q0.y, (int)q0.z, (int)q0.w, (int)q1.x, (int)q1.y, (int)q1.z, (int)q1.w};
    i32x8 Q2Z = {(int)q2.x, (int)q2.y, (int)q2.z, (int)q2.w, 0, 0, 0, 0};
    asm volatile("" : "+v"(Q01), "+v"(Q2Z));
    i32x8 PP = {0, 0, 0, 0, 0, 0, 0, 0};
    f32x16 o0, o1, negm;
#pragma unroll
    for (int r = 0; r < 16; ++r) { o0[r] = 0.f; o1[r] = 0.f; negm[r] = 0.f; }
    AT_PIN(negm);
    float mref = 0.f, l0 = 0.f, l1 = 0.f;
    AT_WAIT_BAR(5);
    int slot = 0;
    for (int u = 0; u < NU; ++u) {
        const bool pf = u + 2 < NU;
        const int s2 = slot == 0 ? 2 : slot - 1;
#pragma unroll
        for (int g = 0; g < 2; ++g) {
            if (pf && (wid & 1) == g) attn_dma(lds0, s2, srdK, srdV, koff0 + (unsigned)(u + 2) * 24576u, voff0 + (unsigned)(u + 2) * 16384u, wid, lane);
            const unsigned char* kb = lds + slot * AT_STAGE + g * 12288 + lane * 16;
            const unsigned char* vb = lds + slot * AT_STAGE + 24576 + g * 8192 + lane * 16;
            f32x16 x0, x1, y0, y1;
            { const u32x4 a0 = *(const u32x4*)(kb), a1 = *(const u32x4*)(kb + 1024), a2 = *(const u32x4*)(kb + 2048);
              const u32x4 b0 = *(const u32x4*)(kb + 3072), b1 = *(const u32x4*)(kb + 4096), b2 = *(const u32x4*)(kb + 5120);
              i32x8 KA = {(int)a0.x, (int)a0.y, (int)a0.z, (int)a0.w, (int)a1.x, (int)a1.y, (int)a1.z, (int)a1.w};
              i32x8 KB = {(int)b0.x, (int)b0.y, (int)b0.z, (int)b0.w, (int)b1.x, (int)b1.y, (int)b1.z, (int)b1.w};
              x0 = mfma8v(KA, Q01, negm); x1 = mfma8v(KB, Q01, negm);
              KA[0] = (int)a2.x; KA[1] = (int)a2.y; KA[2] = (int)a2.z; KA[3] = (int)a2.w;
              KB[0] = (int)b2.x; KB[1] = (int)b2.y; KB[2] = (int)b2.z; KB[3] = (int)b2.w;
              x0 = mfma8v(KA, Q2Z, x0); x1 = mfma8v(KB, Q2Z, x1); }
            __builtin_amdgcn_sched_barrier(0);
            { const u32x4 c0 = *(const u32x4*)(kb + 6144), c1 = *(const u32x4*)(kb + 7168), c2 = *(const u32x4*)(kb + 8192);
              const u32x4 d0 = *(const u32x4*)(kb + 9216), d1 = *(const u32x4*)(kb + 10240), d2 = *(const u32x4*)(kb + 11264);
              i32x8 KC = {(int)c0.x, (int)c0.y, (int)c0.z, (int)c0.w, (int)c1.x, (int)c1.y, (int)c1.z, (int)c1.w};
              i32x8 KD = {(int)d0.x, (int)d0.y, (int)d0.z, (int)d0.w, (int)d1.x, (int)d1.y, (int)d1.z, (int)d1.w};
              y0 = mfma8v(KC, Q01, negm); y1 = mfma8v(KD, Q01, negm);
              KC[0] = (int)c2.x; KC[1] = (int)c2.y; KC[2] = (int)c2.z; KC[3] = (int)c2.w;
              KD[0] = (int)d2.x; KD[1] = (int)d2.y; KD[2] = (int)d2.z; KD[3] = (int)d2.w;
              y0 = mfma8v(KC, Q2Z, y0); y1 = mfma8v(KD, Q2Z, y1); }
            asm volatile("s_nop 15\n\ts_nop 15" : "+v"(x0), "+v"(x1), "+v"(y0), "+v"(y1));
            float ma = max3f(x0[0], x0[1], x1[0]), mb = max3f(x0[2], x0[3], x1[1]); ma = max3f(ma, x1[2], x1[3]);
            float mc = max3f(y0[0], y0[1], y1[0]), md = max3f(y0[2], y0[3], y1[1]); mc = max3f(mc, y1[2], y1[3]);
#pragma unroll
            for (int r = 4; r < 16; r += 4) {
                ma = max3f(ma, x0[r], x0[r + 1]); mb = max3f(mb, x0[r + 2], x0[r + 3]); mc = max3f(mc, y0[r], y0[r + 1]); md = max3f(md, y0[r + 2], y0[r + 3]);
                ma = max3f(ma, x1[r], x1[r + 1]); mb = max3f(mb, x1[r + 2], x1[r + 3]); mc = max3f(mc, y1[r], y1[r + 1]); md = max3f(md, y1[r + 2], y1[r + 3]);
            }
            float mx = max2f_pad(max3f(ma, mb, mc), md);
            { auto rr = __builtin_amdgcn_permlane32_swap(__float_as_uint(mx), __float_as_uint(mx), false, false); mx = fmaxf(__uint_as_float(rr[0]), __uint_as_float(rr[1])); }
            const bool first = (u == 0) && (g == 0);
            if (__builtin_expect(first || __any(mx > 7.5f), 0)) {
                const float d = first ? mx - 6.f : fmaxf(mx - 6.f, 0.f);
                mref += d;
                const float f = __builtin_amdgcn_exp2f(-d);
#pragma unroll
                for (int r = 0; r < 16; ++r) { x0[r] -= d; x1[r] -= d; y0[r] -= d; y1[r] -= d; o0[r] *= f; o1[r] *= f; negm[r] = -mref; }
                l0 *= f; l1 *= f;
                AT_PIN(negm);
            }
#pragma unroll
            for (int r = 0; r < 16; ++r) { x0[r] = __builtin_amdgcn_exp2f(x0[r]); x1[r] = __builtin_amdgcn_exp2f(x1[r]); }
#pragma unroll
            for (int r = 0; r < 16; ++r) { l0 += x0[r]; AT_PIN(l0); l1 += x1[r]; AT_PIN(l1); }
            pack32_fp8_into(PP, x0, x1);
            { const u32x4 v00 = *(const u32x4*)(vb), v01 = *(const u32x4*)(vb + 1024), v10 = *(const u32x4*)(vb + 2048), v11 = *(const u32x4*)(vb + 3072);
              const i32x8 V0 = {(int)v00.x, (int)v00.y, (int)v00.z, (int)v00.w, (int)v01.x, (int)v01.y, (int)v01.z, (int)v01.w};
              const i32x8 V1 = {(int)v10.x, (int)v10.y, (int)v10.z, (int)v10.w, (int)v11.x, (int)v11.y, (int)v11.z, (int)v11.w};
              o0 = mfma8v(V0, PP, o0); o1 = mfma8v(V1, PP, o1); }
#pragma unroll
            for (int r = 0; r < 16; ++r) { y0[r] = __builtin_amdgcn_exp2f(y0[r]); y1[r] = __builtin_amdgcn_exp2f(y1[r]); }
#pragma unroll
            for (int r = 0; r < 16; ++r) { l0 += y0[r]; AT_PIN(l0); l1 += y1[r]; AT_PIN(l1); }
            pack32_fp8_into(PP, y0, y1);
            { const u32x4 v00 = *(const u32x4*)(vb + 4096), v01 = *(const u32x4*)(vb + 5120), v10 = *(const u32x4*)(vb + 6144), v11 = *(const u32x4*)(vb + 7168);
              const i32x8 V0 = {(int)v00.x, (int)v00.y, (int)v00.z, (int)v00.w, (int)v01.x, (int)v01.y, (int)v01.z, (int)v01.w};
              const i32x8 V1 = {(int)v10.x, (int)v10.y, (int)v10.z, (int)v10.w, (int)v11.x, (int)v11.y, (int)v11.z, (int)v11.w};
              o0 = mfma8v(V0, PP, o0); o1 = mfma8v(V1, PP, o1); }
        }
        if (pf) AT_WAIT_BAR(5); else AT_WAIT_BAR(0);
        slot = slot == 2 ? 0 : slot + 1;
    }
    const float inv = 1.f / swap32_sum(l0 + l1);
    const int tok = tq0 + r32;
    const bf16_t* sz = (const bf16_t*)(p.ws + WS_SZ) + (size_t)tok * AW + head * 64 + 8 * hi;
    bf16_t* mo = (bf16_t*)(p.ws + WS_MIX2) + (size_t)tok * AW + head * 64 + 8 * hi;
#pragma unroll
    for (int d0 = 0; d0 < 2; ++d0)
#pragma unroll
        for (int q8 = 0; q8 < 2; ++q8) {
            const u32x4 g = *(const u32x4*)(sz + 32 * d0 + 16 * q8);
            float v[8];
#pragma unroll
            for (int e = 0; e < 4; ++e) {
                const float a = d0 == 0 ? o0[8 * q8 + 2 * e] : o1[8 * q8 + 2 * e], b = d0 == 0 ? o0[8 * q8 + 2 * e + 1] : o1[8 * q8 + 2 * e + 1];
                v[2 * e] = a * inv * bf_lo(g[e]); v[2 * e + 1] = b * inv * bf_hi(g[e]);
            }
            *(u32x4*)(mo + 32 * d0 + 16 * q8) = pack8(v);
        }
}


constexpr size_t WS_BAR = 640 * 1024;
#define XB_TMO      128
#define XB_XCNT(j)  (256  + 64 * (j))
#define XB_XSUB(j)  (1280 + 64 * (j))
#define XB_XGEN(j)  (2304 + 64 * (j))
#define XB_TOP      3328
#define XB_TOPGEN   3392
#define XCD_BAR_WORDS 3456
#define XB_SPIN_CAP (1u << 18)
__device__ __forceinline__ unsigned xb_ld(unsigned* p)              { return __hip_atomic_load(p, __ATOMIC_RELAXED, __HIP_MEMORY_SCOPE_AGENT); }
__device__ __forceinline__ unsigned xb_add(unsigned* p, unsigned v) { return __hip_atomic_fetch_add(p, v, __ATOMIC_RELAXED, __HIP_MEMORY_SCOPE_AGENT); }
__device__ __forceinline__ unsigned xb_xcc_id() { return (unsigned)__builtin_amdgcn_s_getreg((3 << 11) | 20) & 0xFu; }
#define XB_SPIN(cond, bar) do { unsigned _sp = 0; while (cond) { __builtin_amdgcn_s_sleep(1); \
    if ((++_sp & 255u) == 0u) { if (xb_ld(&(bar)[XB_TMO])) break; if (_sp > XB_SPIN_CAP) { atomicAdd(&(bar)[XB_TMO], 1u); break; } } } } while (0)
struct XcdBarrier { unsigned* bar; unsigned x; unsigned nloc, nx; };
__device__ __forceinline__ XcdBarrier xcd_barrier_post(unsigned* bar) {
    XcdBarrier b; b.bar = bar; b.x = xb_xcc_id(); b.nloc = 0u; b.nx = 0u;
    if (threadIdx.x == 0) (void)xb_add(&bar[XB_XCNT(b.x)], 1u);
    return b;
}
__device__ __forceinline__ void xcd_barrier_complete(unsigned* bar, unsigned x, unsigned& nloc, unsigned& nx) {
    const unsigned G = gridDim.x * gridDim.y * gridDim.z;
    unsigned sum, cnt, mine, sp = 0u;
    for (;;) {
        sum = 0u; cnt = 0u; mine = 0u;
#pragma unroll
        for (unsigned j = 0; j < 16; ++j) { const unsigned c = xb_ld(&bar[XB_XCNT(j)]); sum += c; cnt += (c > 0u) ? 1u : 0u; mine = (j == x) ? c : mine; }
        if (sum == G) break;
        __builtin_amdgcn_s_sleep(1);
        if ((++sp & 255u) == 0u) { if (xb_ld(&bar[XB_TMO])) break; if (sp > XB_SPIN_CAP) { atomicAdd(&bar[XB_TMO], 1u); break; } }
    }
    nloc = mine > 0u ? mine : 1u; nx = cnt > 0u ? cnt : 1u;
}
__device__ __forceinline__ void xcd_barrier(XcdBarrier& b) {
    asm volatile("s_waitcnt vmcnt(0)" ::: "memory");
    __syncthreads();
    if (threadIdx.x == 0) {
        unsigned* bar = b.bar;
        __builtin_amdgcn_s_waitcnt(0);
        unsigned nloc = b.nloc, nx = b.nx;
        if (nloc == 0u) { xcd_barrier_complete(bar, b.x, nloc, nx); b.nloc = nloc; b.nx = nx; }
        const unsigned old = xb_add(&bar[XB_XSUB(b.x)], 1u);
        const unsigned gen = old / nloc;
        if (old + 1u == (gen + 1u) * nloc) {
            __builtin_amdgcn_fence(__ATOMIC_RELEASE, "agent");
            asm volatile("s_waitcnt vmcnt(0)" ::: "memory");
            const unsigned og = xb_add(&bar[XB_TOP], 1u);
            const unsigned tg = og / nx;
            if (og + 1u == (tg + 1u) * nx) xb_add(&bar[XB_TOPGEN], 1u);
            else XB_SPIN(xb_ld(&bar[XB_TOPGEN]) == tg, bar);
            __builtin_amdgcn_fence(__ATOMIC_ACQUIRE, "agent");
            xb_add(&bar[XB_XGEN(b.x)], 1u);
            asm volatile("s_waitcnt vmcnt(0)" ::: "memory");
        } else {
            XB_SPIN(xb_ld(&bar[XB_XGEN(b.x)]) == gen, bar);
            __builtin_amdgcn_fence(__ATOMIC_ACQUIRE, "agent");
            asm volatile("s_waitcnt vmcnt(0)" ::: "memory");
        }
    }
    __syncthreads();
}

__global__ void __launch_bounds__(NTHR, 2) fwd_kernel(Params p) {
    extern __shared__ __attribute__((aligned(16))) unsigned char lds[];
    cg::grid_group grid = cg::this_grid();
    const int G = gridDim.x, bx = blockIdx.x, tid = threadIdx.x;
    const int gtid = bx * NTHR + tid, gthreads = G * NTHR;
    const int xcd = bx & 7, lb = bx >> 3, GX = G >> 3;
    unsigned char* ws = p.ws;

    __syncthreads();
    XcdBarrier xbar = xcd_barrier_post((unsigned*)(ws + WS_BAR));
    if (p.ws == nullptr) grid.sync();
    phase0(p, gtid, gthreads);
    xcd_barrier(xbar);

    { EpiIn E{ws}; const bf16_t* xn = (const bf16_t*)(ws + WS_XN); const bf16_t* W = (const bf16_t*)(ws + WS_WIN);
      gemm_dma<4, 2, 0>(lds, xn, xn, 1 << 30, DM, W, DM, 13, xcd, lb, GX, E); }
    xcd_barrier(xbar);

    { EpiQ E{ws}; const bf16_t* A = (const bf16_t*)(ws + WS_QLAT); const bf16_t* W = (const bf16_t*)(ws + WS_WUQ);
      gemm_dma<2, 3, 0>(lds, A, A, 1 << 30, QLR, W, QLR, 2, xcd, lb, GX, E); }
    { EpiKV E{ws}; const bf16_t* A = (const bf16_t*)(ws + WS_KVLAT); const bf16_t* W = (const bf16_t*)(ws + WS_WUKV);
      gemm_dma<4, 2, 1>(lds, A, A, 1 << 30, KVLR, W, KVLR, 4, xcd, lb, GX, E); }
    xcd_barrier(xbar);

    for (int w = lb; w < 128; w += GX) { const int bl = w >> 6, qblk = w & 63; attn_unit(lds, p, xcd, NTOK_P + bl * SEQ_S, SEQ_S, qblk); }
    { unsigned* tick = (unsigned*)(ws + WS_BAR) + 3584 + 64 * xcd;
      for (;;) {
          if (tid == 0) *(volatile unsigned*)lds = xb_add(tick, 1u);
          __syncthreads();
          const unsigned w2 = *(volatile unsigned*)lds;
          __syncthreads();
          if (w2 >= 64u) break;
          attn_unit(lds, p, (int)(w2 >> 3), xcd * SEQ_P, SEQ_P, (int)(w2 & 7));
      } }
    conv_phase(p, gtid, gthreads);
    xcd_barrier(xbar);

    { EpiOut E{ws}; const bf16_t* A0 = (const bf16_t*)(ws + WS_MIXA); const bf16_t* A1 = (const bf16_t*)(ws + WS_MIX2); const bf16_t* W = (const bf16_t*)(ws + WS_WOUT);
      gemm_dma<4, 2, 0>(lds, A0, A1, 512, CW, W, DM, 4, xcd, lb, GX, E); }
    xcd_barrier(xbar);

    { const float* ssq = (const float*)(ws + WS_SSQ) + 2 * NTOK; const bf16_t* ob = (const bf16_t*)(ws + WS_XN);
      const int lane = tid & 63, gw = gtid >> 6, nw = gthreads >> 6;
      f32x4 g[4];
#pragma unroll
      for (int j = 0; j < 4; ++j) g[j] = *(const f32x4*)(p.norm_post + 4 * lane + 256 * j);
      for (int row = gw * 2; row < NTOK; row += nw * 2) {
          f32x4 xv[2][4]; u32x2 ov[2][4]; float rs[2];
#pragma unroll
          for (int u = 0; u < 2; ++u) {
              const float* xr = xrow(p, row + u) + 4 * lane; const bf16_t* orow = ob + (size_t)(row + u) * DM + 4 * lane;
#pragma unroll
              for (int j = 0; j < 4; ++j) { xv[u][j] = __builtin_nontemporal_load((const f32x4*)(xr + 256 * j)); ov[u][j] = __builtin_nontemporal_load((const u32x2*)(orow + 256 * j)); }
              rs[u] = rsqrtf(ssq[row + u] * (1.f / DM) + EPS);
          }
#pragma unroll
          for (int u = 0; u < 2; ++u) {
              float* yr = p.out + (size_t)(row + u) * DM + 4 * lane;
#pragma unroll
              for (int j = 0; j < 4; ++j) {
                  f32x4 o; o.x = bf_lo(ov[u][j].x); o.y = bf_hi(ov[u][j].x); o.z = bf_lo(ov[u][j].y); o.w = bf_hi(ov[u][j].y);
                  __builtin_nontemporal_store(xv[u][j] + o * rs[u] * g[j], (f32x4*)(yr + 256 * j));
              }
          }
      } }
}

extern "C" void kernel_launch(void* const* d_in, const int* in_sizes, int n_in, void* d_out, int out_size, void* d_ws, size_t ws_size, hipStream_t stream) {
    static int grid_blocks = 0;
    if (!grid_blocks) {
        int dev = 0, cus = 0, per_cu = 0;
        hipGetDevice(&dev);
        hipDeviceGetAttribute(&cus, hipDeviceAttributeMultiprocessorCount, dev);
        hipFuncSetAttribute((const void*)fwd_kernel, hipFuncAttributeMaxDynamicSharedMemorySize, LDS_BYTES);
        hipOccupancyMaxActiveBlocksPerMultiprocessor(&per_cu, (const void*)fwd_kernel, NTHR, LDS_BYTES);
        if (per_cu < 1) per_cu = 1;
        if (per_cu > 1) per_cu = 1;
        grid_blocks = cus * per_cu;
        if (ws_size < WS_END) fprintf(stderr, "kernel_launch: workspace too small (%zu < %zu)\n", ws_size, (size_t)WS_END);
    }
    (void)hipMemsetAsync((unsigned char*)d_ws + WS_BAR, 0, 16384, stream);
    Params p{};
    p.x_prompt = (const float*)d_in[0]; p.x_sample = (const float*)d_in[1]; p.norm_pre = (const float*)d_in[2]; p.w_in = (const float*)d_in[3];
    p.conv_w = (const float*)d_in[4]; p.q_norm = (const float*)d_in[5]; p.w_uq = (const float*)d_in[6]; p.kv_norm = (const float*)d_in[7];
    p.w_ukv = (const float*)d_in[8]; p.w_out = (const float*)d_in[9]; p.norm_post = (const float*)d_in[10];
    p.out = (float*)d_out; p.ws = (unsigned char*)d_ws;
    void* args[] = {&p};
    hipError_t e = hipLaunchCooperativeKernel((const void*)fwd_kernel, dim3(grid_blocks), dim3(NTHR), args, LDS_BYTES, stream);
    if (e != hipSuccess) fprintf(stderr, "cooperative launch failed: %s (grid %d)\n", hipGetErrorString(e), grid_blocks);
}
```

```cpp
#include <hip/hip_runtime.h>
#include <hip/hip_cooperative_groups.h>
#include <cstdio>
#include <cstdint>
namespace cg = cooperative_groups;

typedef unsigned short bf16_t;
typedef short bf16x8 __attribute__((ext_vector_type(8)));
typedef float f32x16 __attribute__((ext_vector_type(16)));
typedef float f32x4 __attribute__((ext_vector_type(4)));
typedef float f32x2 __attribute__((ext_vector_type(2)));
typedef unsigned u32x4 __attribute__((ext_vector_type(4)));
typedef unsigned u32x2 __attribute__((ext_vector_type(2)));
#define LAS __attribute__((address_space(3)))

constexpr int DM = 1024, NTOK = 49152, NTOK_P = 16384, SEQ_P = 2048, SEQ_S = 16384;
constexpr int CW = 512, NH = 8, QLR = 384, KVLR = 256, ROPE = 32, AW = 512;
constexpr int NIN = 3328;
constexpr int NBLK32 = NTOK / 32;
constexpr float EPS = 1e-6f;
constexpr float C2 = 0.14724444f;

constexpr size_t MiB = 1u << 20;
constexpr size_t WS_SSQ = 0;
constexpr size_t WS_COS = 1 * MiB, WS_SIN = 2 * MiB;
constexpr size_t WS_WIN = 3 * MiB;
constexpr size_t WS_WUQ = 10 * MiB;
constexpr size_t WS_WUKV = 11 * MiB;
constexpr size_t WS_WOUT = 12 * MiB;
constexpr size_t WS_XN = 16 * MiB;
constexpr size_t WS_QF = 16 * MiB;
constexpr size_t WS_CU = 112 * MiB;
constexpr size_t WS_GZ = 160 * MiB;
constexpr size_t WS_SZ = 208 * MiB;
constexpr size_t WS_QLAT = 256 * MiB;
constexpr size_t WS_KVLAT = 292 * MiB;
constexpr size_t WS_MIX2 = 256 * MiB;
constexpr size_t WS_KF = 316 * MiB;
constexpr size_t WS_VF = 388 * MiB;
constexpr size_t WS_MIXA = 436 * MiB;
constexpr size_t WS_END = 484 * MiB;

constexpr int LDS_BYTES = 131072;
constexpr int NTHR = 512;

struct Params {
    const float* x_prompt; const float* x_sample; const float* norm_pre; const float* w_in; const float* conv_w;
    const float* q_norm; const float* w_uq; const float* kv_norm; const float* w_ukv; const float* w_out; const float* norm_post;
    float* out; unsigned char* ws;
};

__device__ __forceinline__ unsigned pk_bf16(float lo, float hi) {
    typedef __bf16 b2 __attribute__((ext_vector_type(2)));
    f32x2 v = {lo, hi}; b2 b = __builtin_convertvector(v, b2); return __builtin_bit_cast(unsigned, b);
}
__device__ __forceinline__ float bf_lo(unsigned u) { return __uint_as_float(u << 16); }
__device__ __forceinline__ float bf_hi(unsigned u) { return __uint_as_float(u & 0xffff0000u); }
__device__ __forceinline__ u32x4 pack8(const float* v) {
    u32x4 w; w.x = pk_bf16(v[0], v[1]); w.y = pk_bf16(v[2], v[3]); w.z = pk_bf16(v[4], v[5]); w.w = pk_bf16(v[6], v[7]); return w;
}
typedef int i32x8 __attribute__((ext_vector_type(8)));
__device__ __forceinline__ u32x4 pack16_fp8(const float* v) {
    u32x4 w;
#pragma unroll
    for (int k = 0; k < 4; ++k) { int t = __builtin_amdgcn_cvt_pk_fp8_f32(v[4 * k], v[4 * k + 1], 0, false); t = __builtin_amdgcn_cvt_pk_fp8_f32(v[4 * k + 2], v[4 * k + 3], t, true); w[k] = (unsigned)t; }
    return w;
}
__device__ __forceinline__ f32x16 mfma8(u32x4 a0, u32x4 a1, u32x4 b0, u32x4 b1, f32x16 c) {
    const i32x8 A = {(int)a0.x, (int)a0.y, (int)a0.z, (int)a0.w, (int)a1.x, (int)a1.y, (int)a1.z, (int)a1.w};
    const i32x8 B = {(int)b0.x, (int)b0.y, (int)b0.z, (int)b0.w, (int)b1.x, (int)b1.y, (int)b1.z, (int)b1.w};
    return __builtin_amdgcn_mfma_scale_f32_32x32x64_f8f6f4(A, B, c, 0, 0, 0, 0x7f7f7f7f, 0, 0x7f7f7f7f);
}
__device__ __forceinline__ f32x16 mfma8v(i32x8 A, i32x8 B, f32x16 c) { return __builtin_amdgcn_mfma_scale_f32_32x32x64_f8f6f4(A, B, c, 0, 0, 0, 0x7f7f7f7f, 0, 0x7f7f7f7f); }
__device__ __forceinline__ void pack32_fp8_into(i32x8& P, const f32x16& s0, const f32x16& s1) {
#pragma unroll
    for (int k = 0; k < 4; ++k) { int t = __builtin_amdgcn_cvt_pk_fp8_f32(s0[4 * k], s0[4 * k + 1], P[k], false); P[k] = __builtin_amdgcn_cvt_pk_fp8_f32(s0[4 * k + 2], s0[4 * k + 3], t, true); }
#pragma unroll
    for (int k = 0; k < 4; ++k) { int t = __builtin_amdgcn_cvt_pk_fp8_f32(s1[4 * k], s1[4 * k + 1], P[4 + k], false); P[4 + k] = __builtin_amdgcn_cvt_pk_fp8_f32(s1[4 * k + 2], s1[4 * k + 3], t, true); }
}
__device__ __forceinline__ float silu_f(float z) { return z / (1.f + __expf(-z)); }
__device__ __forceinline__ int cperm(int p) { const int hp = (p >> 2) & 1, r = (p & 3) + 4 * (p >> 3); return 16 * (r >> 3) + 8 * hp + (r & 7); }
__device__ __forceinline__ int crow(int r, int hi) { return (r & 3) + 8 * (r >> 2) + 4 * hi; }
__device__ __forceinline__ float swap32_max(float m) {
    auto rr = __builtin_amdgcn_permlane32_swap(__float_as_uint(m), __float_as_uint(m), false, false);
    return fmaxf(__uint_as_float(rr[0]), __uint_as_float(rr[1]));
}
__device__ __forceinline__ float swap32_sum(float m) {
    auto rr = __builtin_amdgcn_permlane32_swap(__float_as_uint(m), __float_as_uint(m), false, false);
    return __uint_as_float(rr[0]) + __uint_as_float(rr[1]);
}
__device__ __forceinline__ float wave_sum(float v) {
#pragma unroll
    for (int o = 1; o < 64; o <<= 1) v += __shfl_xor(v, o);
    return v;
}
__device__ __forceinline__ const float* xrow(const Params& p, int tok) {
    return tok < NTOK_P ? p.x_prompt + (size_t)tok * DM : p.x_sample + (size_t)(tok - NTOK_P) * DM;
}
__device__ __forceinline__ int tok_pos(int tok) { return tok < NTOK_P ? (tok & (SEQ_P - 1)) : (tok & (SEQ_S - 1)); }

__device__ __forceinline__ void glds16(const void* gsrc, unsigned lds_dst) {
    unsigned keep;
    asm volatile("s_mov_b32 %0, m0\n\ts_mov_b32 m0, %2\n\ts_nop 0\n\tglobal_load_lds_dwordx4 %1, off\n\ts_mov_b32 m0, %0" : "=&s"(keep) : "v"(gsrc), "s"(lds_dst) : "memory");
}
#define AT_WAIT_BAR(N) asm volatile("s_waitcnt vmcnt(" #N ") lgkmcnt(0)\n\ts_barrier" ::: "memory")
typedef __amdgpu_buffer_rsrc_t srd_t;
__device__ __forceinline__ srd_t make_srd(const void* base) { return __builtin_amdgcn_make_buffer_rsrc((void*)base, (short)0, 0x7ffffffe, 0x00020000); }
__device__ __forceinline__ void bdma16(unsigned m0v, unsigned voff, srd_t srd, unsigned soff) {
    asm volatile("s_nop 4\n\ts_mov_b32 m0, %0\n\ts_nop 0\n\tbuffer_load_dwordx4 %1, %2, %3 offen lds" :: "s"(m0v), "v"(voff), "s"(srd), "s"(soff) : "m0", "memory");
}
__device__ __forceinline__ unsigned rflu(unsigned v) { return (unsigned)__builtin_amdgcn_readfirstlane((int)v); }

__device__ __forceinline__ int win_src(int np) {
    const int T = np >> 7, w = np & 127;
    if (T < 16) { const int wn = w >> 6, j = (w >> 5) & 1, q = (w >> 4) & 1, i16 = w & 15; return (2 * j + q) * 512 + 32 * T + 16 * wn + i16; }
    if (T < 21) return np;
    if (T < 25) return 2720 + (np - 2688);
    return w < 32 ? 2688 + w : -1;
}
template <int MODE>
__device__ __forceinline__ void prep_weight(const float* __restrict__ w, const float* __restrict__ gain, bf16_t* WT, int K, int Nsrc, int Ndst, int gtid, int gthreads) {
    const int items = Ndst * (K / 8);
    for (int id = gtid; id < items; id += gthreads) {
        const int n = id % Ndst, kc = id / Ndst, k0 = kc * 8;
        const int src = (MODE == 1) ? win_src(n) : n;
        float v[8];
#pragma unroll
        for (int e = 0; e < 8; ++e) v[e] = (src >= 0) ? w[(size_t)(k0 + e) * Nsrc + src] * (gain ? gain[k0 + e] : 1.f) : 0.f;
        *(u32x4*)(WT + (size_t)n * K + k0) = pack8(v);
    }
}
__device__ __forceinline__ void rope_entry(int pos, int i, float& c, float& s) {
    const int a = i & 3, b = i >> 2;
    double base = a == 0 ? 1.0 : a == 1 ? 0.5623413251903491 : a == 2 ? 0.31622776601683794 : 0.1778279410038923;
    double sc = b == 0 ? 1.0 : b == 1 ? 0.1 : b == 2 ? 0.01 : 0.001;
    const float freq = (float)(base * sc);
    const float angf = (float)pos * freq;
    const double x = (double)angf;
    const double kq = rint(x * 0.6366197723675814);
    const double r = (x - kq * 1.5707963267948966) - kq * 6.123233995736766e-17;
    const double r2 = r * r;
    const double sn = r * (1.0 + r2 * (-1.0 / 6 + r2 * (1.0 / 120 + r2 * (-1.0 / 5040 + r2 * (1.0 / 362880 + r2 * (-1.0 / 39916800))))));
    const double cs = 1.0 + r2 * (-0.5 + r2 * (1.0 / 24 + r2 * (-1.0 / 720 + r2 * (1.0 / 40320 + r2 * (-1.0 / 3628800 + r2 * (1.0 / 479001600))))));
    const int qd = ((int)kq) & 3;
    const double so = qd == 0 ? sn : qd == 1 ? cs : qd == 2 ? -sn : -cs;
    const double co = qd == 0 ? cs : qd == 1 ? -sn : qd == 2 ? -cs : sn;
    c = (float)co; s = (float)so;
}
__device__ __forceinline__ void phase0(const Params& p, int gtid, int gthreads) {
    unsigned char* ws = p.ws;
    float* ssq = (float*)(ws + WS_SSQ);
    for (int i = gtid; i < 3 * NTOK; i += gthreads) ssq[i] = 0.f;
    float* ct = (float*)(ws + WS_COS); float* st = (float*)(ws + WS_SIN);
    for (int i = gtid; i < SEQ_S * 16; i += gthreads) { float c, s; rope_entry(i >> 4, i & 15, c, s); ct[i] = c; st[i] = s; }
    prep_weight<1>(p.w_in, p.norm_pre, (bf16_t*)(ws + WS_WIN), DM, 3232, NIN, gtid, gthreads);
    prep_weight<0>(p.w_uq, p.q_norm, (bf16_t*)(ws + WS_WUQ), QLR, 768, 768, gtid, gthreads);
    prep_weight<0>(p.w_ukv, p.kv_norm, (bf16_t*)(ws + WS_WUKV), KVLR, 1024, 1024, gtid, gthreads);
    prep_weight<0>(p.w_out, nullptr, (bf16_t*)(ws + WS_WOUT), DM, 1024, 1024, gtid, gthreads);
    const int gw = gtid >> 6, nw = gthreads >> 6, lane = threadIdx.x & 63;
    bf16_t* xn = (bf16_t*)(ws + WS_XN);
    for (int row = gw * 4; row < NTOK; row += nw * 4) {
        f32x4 v[4][4]; float s[4];
#pragma unroll
        for (int u = 0; u < 4; ++u) {
            const f32x4* xr = (const f32x4*)xrow(p, row + u) + lane; s[u] = 0.f;
#pragma unroll
            for (int j = 0; j < 4; ++j) { v[u][j] = __builtin_nontemporal_load(xr + 64 * j); }
        }
#pragma unroll
        for (int u = 0; u < 4; ++u) {
#pragma unroll
            for (int j = 0; j < 4; ++j) s[u] += (v[u][j].x * v[u][j].x + v[u][j].y * v[u][j].y) + (v[u][j].z * v[u][j].z + v[u][j].w * v[u][j].w);
            const float rs = rsqrtf(wave_sum(s[u]) * (1.f / DM) + EPS);
            u32x2* o = (u32x2*)(xn + (size_t)(row + u) * DM) + lane;
#pragma unroll
            for (int j = 0; j < 4; ++j) { u32x2 w; w.x = pk_bf16(v[u][j].x * rs, v[u][j].y * rs); w.y = pk_bf16(v[u][j].z * rs, v[u][j].w * rs); o[64 * j] = w; }
        }
    }
}

__device__ __forceinline__ void tile_map(int w, int NT, int xcd, int MPX, int& mt, int& nt) {
    const int g = w / (8 * NT), rem = w % (8 * NT);
    nt = rem >> 3; mt = xcd * MPX + g * 8 + (rem & 7);
}
template <int MI, int NJ, int MODE, class Epi>
__device__ __forceinline__ void gemm_dma(unsigned char* lds, const bf16_t* __restrict__ A0, const bf16_t* __restrict__ A1, int ksplit, int lda,
                                         const bf16_t* __restrict__ Bt, int K, int NT, int xcd, int lb, int GX, const Epi& epi) {
    constexpr int NSA = 4 * MI, NSUB = 4 * MI + 8 * NJ, STAGE = NSUB * 1024, NIT = NSUB / 8, NITA = NSA / 8, BOFF = NSA * 1024, MPX = 96 / MI;
    static_assert(4 * STAGE <= LDS_BYTES && NSUB % 8 == 0 && NSA % 8 == 0, "lds");
    const int tid = threadIdx.x, lane = tid & 63, wid = __builtin_amdgcn_readfirstlane(tid >> 6), wm = wid >> 2, wn = wid & 3;
    const int r32 = lane & 31, hi = lane >> 5;
    const unsigned lds0 = rflu((unsigned)(uintptr_t)lds);
    const int nk = K / 32, count = MPX * NT;
    int w = lb;
    if (w >= count) return;
    int mt, nt; tile_map(w, NT, xcd, MPX, mt, nt);
    const int rowl = lane >> 2, colsw = 8 * ((lane & 3) ^ ((lane >> 4) & 3));
    const unsigned voffA = (unsigned)((rowl * lda + colsw) * 2), voffB = (unsigned)((rowl * K + colsw) * 2);
    const srd_t srdA0 = make_srd(A0), srdA1 = make_srd(A1), srdB = make_srd(Bt);
    auto dma = [&](int tmt, int tnt, int kt, int stage) {
        const int k0 = kt * 32;
        const bool lo = k0 < ksplit;
        const unsigned sa = (unsigned)(tmt * 64 * MI) * (unsigned)(lda * 2) + (unsigned)((lo ? k0 : k0 - ksplit) * 2);
        const unsigned sbb = (unsigned)(tnt * 128 * NJ) * (unsigned)(K * 2) + (unsigned)(k0 * 2);
#pragma unroll
        for (int it = 0; it < NIT; ++it) {
            const int f = wid + 8 * it;
            const unsigned m0v = rflu(lds0 + (unsigned)(stage * STAGE + f * 1024));
            if (it < NITA) { const unsigned so = rflu(sa + (unsigned)(f * 16) * (unsigned)(lda * 2)); if (lo) bdma16(m0v, voffA, srdA0, so); else bdma16(m0v, voffA, srdA1, so); }
            else { const unsigned so = rflu(sbb + (unsigned)((f - NSA) * 16) * (unsigned)(K * 2)); bdma16(m0v, voffB, srdB, so); }
        }
    };
    const int cb = cperm(r32);
    const int arow = (wm * 32 * MI + r32), brow = (wn * 32 * NJ + cb);
    const int abase = (arow >> 4) * 1024 + (arow & 15) * 64, ax = (arow >> 2) & 3;
    const int bbase = BOFF + (brow >> 4) * 1024 + (brow & 15) * 64, bx_ = (brow >> 2) & 3;
    const bool swp = (MODE == 0) || ((wn & 1) == 0);
    f32x16 acc[MI][NJ];
    auto compute = [&](int stage) {
        const unsigned char* base = lds + stage * STAGE;
#pragma unroll
        for (int kk = 0; kk < 2; ++kk) {
            bf16x8 af[MI], bfr[NJ];
            const int ca = ((2 * kk + hi) ^ ax) << 4, cbb = ((2 * kk + hi) ^ bx_) << 4;
#pragma unroll
            for (int i = 0; i < MI; ++i) af[i] = *(const bf16x8*)(base + abase + i * 2048 + ca);
#pragma unroll
            for (int j = 0; j < NJ; ++j) bfr[j] = *(const bf16x8*)(base + bbase + j * 2048 + cbb);
#pragma unroll
            for (int i = 0; i < MI; ++i)
#pragma unroll
                for (int j = 0; j < NJ; ++j) {
                    if (MODE == 0) acc[i][j] = __builtin_amdgcn_mfma_f32_32x32x16_bf16(bfr[j], af[i], acc[i][j], 0, 0, 0);
                    else { const bf16x8 xa = swp ? bfr[j] : af[i], xb = swp ? af[i] : bfr[j]; acc[i][j] = __builtin_amdgcn_mfma_f32_32x32x16_bf16(xa, xb, acc[i][j], 0, 0, 0); }
                }
        }
    };
    auto dma2 = [&](int tmt, int tnt, int kt2, int sb) { dma(tmt, tnt, 2 * kt2, 2 * sb); dma(tmt, tnt, 2 * kt2 + 1, 2 * sb + 1); };
    dma2(mt, nt, 0, 0);
    int sb = 0;
    const int nk2 = nk >> 1;
    for (;;) {
        const int wnx = w + GX; const bool has_next = wnx < count;
        int mt2 = mt, nt2 = nt; if (has_next) tile_map(wnx, NT, xcd, MPX, mt2, nt2);
#pragma unroll
        for (int i = 0; i < MI; ++i)
#pragma unroll
            for (int j = 0; j < NJ; ++j)
#pragma unroll
                for (int r = 0; r < 16; ++r) acc[i][j][r] = 0.f;
        AT_WAIT_BAR(0);
        for (int kt2 = 0; kt2 < nk2; ++kt2) {
            const bool last = kt2 + 1 == nk2;
            if (wm == 0) { if (!last) dma2(mt, nt, kt2 + 1, sb ^ 1); else if (has_next) dma2(mt2, nt2, 0, sb ^ 1); }
            compute(2 * sb);
            if (wm != 0) { if (!last) dma2(mt, nt, kt2 + 1, sb ^ 1); else if (has_next) dma2(mt2, nt2, 0, sb ^ 1); }
            compute(2 * sb + 1);
            if (!last) AT_WAIT_BAR(0);
            sb ^= 1;
        }
        epi(acc, mt, nt * 2 + (wn >> 1), wm, wn & 1, r32, hi);
        if (!has_next) break;
        w = wnx; mt = mt2; nt = nt2;
    }
    AT_WAIT_BAR(0);
}

struct EpiIn {
    unsigned char* ws;
    template <int MI> __device__ __forceinline__ void operator()(f32x16 (&acc)[MI][2], int mt, int nt, int wm, int wn, int r32, int hi) const {
        const int lane = r32 + 32 * hi;
        if (nt < 16) {
            bf16_t* cu = (bf16_t*)(ws + WS_CU); bf16_t* gz = (bf16_t*)(ws + WS_GZ);
#pragma unroll
            for (int i = 0; i < MI; ++i) {
                const int tok = mt * (64 * MI) + wm * (32 * MI) + 32 * i + r32; const int ch0 = 32 * nt + 16 * wn + 8 * hi;
                float a[8], b[8];
#pragma unroll
                for (int e = 0; e < 8; ++e) { const float u = acc[i][0][e], B = acc[i][0][8 + e], C = acc[i][1][e], z = acc[i][1][8 + e]; a[e] = C * u; b[e] = B * silu_f(z); }
                *(u32x4*)(cu + (size_t)tok * CW + ch0) = pack8(a);
                *(u32x4*)(gz + (size_t)tok * CW + ch0) = pack8(b);
            }
        } else if (nt < 21) {
            const bool isq = nt < 19;
            bf16_t* dst = (bf16_t*)(ws + (isq ? WS_QLAT : WS_KVLAT)); const int ld = isq ? QLR : KVLR; const int cb = (isq ? (nt - 16) : (nt - 19)) * 128 + wn * 64 + 8 * hi;
            float* ssq = (float*)(ws + WS_SSQ) + (isq ? 0 : NTOK);
#pragma unroll
            for (int i = 0; i < MI; ++i) {
                const int tok = mt * (64 * MI) + wm * (32 * MI) + 32 * i + r32; float ss = 0.f;
#pragma unroll
                for (int j = 0; j < 2; ++j)
#pragma unroll
                    for (int q = 0; q < 2; ++q) {
                        float v[8];
#pragma unroll
                        for (int e = 0; e < 8; ++e) { v[e] = acc[i][j][8 * q + e]; ss += v[e] * v[e]; }
                        *(u32x4*)(dst + (size_t)tok * ld + cb + 32 * j + 16 * q) = pack8(v);
                    }
                ss = swap32_sum(ss);
                if (hi == 0) atomicAdd(ssq + tok, ss);
            }
        } else if (nt < 25) {
            bf16_t* sz = (bf16_t*)(ws + WS_SZ); const int cb = (nt - 21) * 128 + wn * 64 + 8 * hi;
#pragma unroll
            for (int i = 0; i < MI; ++i) {
                const int tok = mt * (64 * MI) + wm * (32 * MI) + 32 * i + r32;
#pragma unroll
                for (int j = 0; j < 2; ++j)
#pragma unroll
                    for (int q = 0; q < 2; ++q) {
                        float v[8];
#pragma unroll
                        for (int e = 0; e < 8; ++e) v[e] = silu_f(acc[i][j][8 * q + e]);
                        *(u32x4*)(sz + (size_t)tok * AW + cb + 32 * j + 16 * q) = pack8(v);
                    }
            }
        } else if (wn == 0) {
            const float* ct = (const float*)(ws + WS_COS); const float* st = (const float*)(ws + WS_SIN);
            unsigned char* kf = ws + WS_KF;
#pragma unroll
            for (int i = 0; i < MI; ++i) {
                const int tok = mt * (64 * MI) + wm * (32 * MI) + 32 * i + r32; const int pos = tok_pos(tok);
                const f32x4 c0 = *(const f32x4*)(ct + pos * 16 + 8 * hi), c1 = *(const f32x4*)(ct + pos * 16 + 8 * hi + 4);
                const f32x4 s0 = *(const f32x4*)(st + pos * 16 + 8 * hi), s1 = *(const f32x4*)(st + pos * 16 + 8 * hi + 4);
                float o[16];
#pragma unroll
                for (int e = 0; e < 8; ++e) { const float c = e < 4 ? c0[e & 3] : c1[e & 3], s = e < 4 ? s0[e & 3] : s1[e & 3]; const float x1 = acc[i][0][e], x2 = acc[i][0][8 + e]; o[e] = x1 * c - x2 * s; o[8 + e] = x2 * c + x1 * s; }
                const u32x4 w1 = pack16_fp8(o); const int blk = tok >> 5;
#pragma unroll
                for (int h = 0; h < NH; ++h) *(u32x4*)(kf + ((size_t)(h * NBLK32 + blk) * 3 + 2) * 1024 + lane * 16) = w1;
            }
        }
    }
};
struct EpiQ {
    unsigned char* ws;
    template <int MI> __device__ __forceinline__ void operator()(f32x16 (&acc)[MI][3], int mt, int nt, int wm, int wn, int r32, int hi) const {
        const int lane = r32 + 32 * hi, head = nt * 2 + wn;
        const float* ssq = (const float*)(ws + WS_SSQ);
        const float* ct = (const float*)(ws + WS_COS); const float* st = (const float*)(ws + WS_SIN);
#pragma unroll
        for (int i = 0; i < MI; ++i) {
            const int tok = mt * (64 * MI) + wm * (32 * MI) + 32 * i + r32; const int pos = tok_pos(tok);
            const float rs = rsqrtf(__hip_atomic_load(ssq + tok, __ATOMIC_RELAXED, __HIP_MEMORY_SCOPE_AGENT) * (1.f / QLR) + EPS) * C2;
            unsigned char* d = ws + WS_QF + ((size_t)(head * NBLK32 + (tok >> 5)) * 3) * 1024 + lane * 16;
#pragma unroll
            for (int j = 0; j < 2; ++j) {
                float v[16];
#pragma unroll
                for (int r = 0; r < 16; ++r) v[r] = acc[i][j][r] * rs;
                *(u32x4*)(d + j * 1024) = pack16_fp8(v);
            }
            const f32x4 c0 = *(const f32x4*)(ct + pos * 16 + 8 * hi), c1 = *(const f32x4*)(ct + pos * 16 + 8 * hi + 4);
            const f32x4 s0 = *(const f32x4*)(st + pos * 16 + 8 * hi), s1 = *(const f32x4*)(st + pos * 16 + 8 * hi + 4);
            float o[16];
#pragma unroll
            for (int e = 0; e < 8; ++e) { const float c = e < 4 ? c0[e & 3] : c1[e & 3], s = e < 4 ? s0[e & 3] : s1[e & 3]; const float x1 = acc[i][2][e] * rs, x2 = acc[i][2][8 + e] * rs; o[e] = x1 * c - x2 * s; o[8 + e] = x2 * c + x1 * s; }
            *(u32x4*)(d + 2 * 1024) = pack16_fp8(o);
        }
    }
};
struct EpiKV {
    unsigned char* ws;
    template <int MI> __device__ __forceinline__ void operator()(f32x16 (&acc)[MI][2], int mt, int nt, int wm, int wn, int r32, int hi) const {
        static_assert(MI % 2 == 0, "V fragments pair two 32-token blocks");
        const int lane = r32 + 32 * hi, head = nt;
        const float* ssq = (const float*)(ws + WS_SSQ) + NTOK;
        if (wn == 0) {
#pragma unroll
            for (int i = 0; i < MI; ++i) {
                const int tok = mt * (64 * MI) + wm * (32 * MI) + 32 * i + r32;
                const float rs = rsqrtf(__hip_atomic_load(ssq + tok, __ATOMIC_RELAXED, __HIP_MEMORY_SCOPE_AGENT) * (1.f / KVLR) + EPS);
                unsigned char* d = ws + WS_KF + ((size_t)(head * NBLK32 + (tok >> 5)) * 3) * 1024 + lane * 16;
#pragma unroll
                for (int j = 0; j < 2; ++j) {
                    float v[16];
#pragma unroll
                    for (int r = 0; r < 16; ++r) v[r] = acc[i][j][r] * rs;
                    *(u32x4*)(d + j * 1024) = pack16_fp8(v);
                }
            }
        } else {
#pragma unroll
            for (int i = 0; i < MI; ++i) {
                const int tb = mt * (64 * MI) + wm * (32 * MI) + 32 * i;
                float rs[16];
#pragma unroll
                for (int r = 0; r < 16; ++r) rs[r] = rsqrtf(__hip_atomic_load(ssq + tb + crow(r, hi), __ATOMIC_RELAXED, __HIP_MEMORY_SCOPE_AGENT) * (1.f / KVLR) + EPS);
                unsigned char* d = ws + WS_VF + ((size_t)(head * (NTOK / 64) + (tb >> 6)) * 4) * 1024 + (i & 1) * 1024 + lane * 16;
#pragma unroll
                for (int j = 0; j < 2; ++j) {
                    float v[16];
#pragma unroll
                    for (int r = 0; r < 16; ++r) v[r] = acc[i][j][r] * rs[r];
                    *(u32x4*)(d + j * 2048) = pack16_fp8(v);
                }
            }
        }
    }
};
struct EpiOut {
    unsigned char* ws;
    template <int MI> __device__ __forceinline__ void operator()(f32x16 (&acc)[MI][2], int mt, int nt, int wm, int wn, int r32, int hi) const {
        float* ssq = (float*)(ws + WS_SSQ) + 2 * NTOK;
        bf16_t* ob = (bf16_t*)(ws + WS_XN);
#pragma unroll
        for (int i = 0; i < MI; ++i) {
            const int tok = mt * (64 * MI) + wm * (32 * MI) + 32 * i + r32; float ss = 0.f;
            bf16_t* d = ob + (size_t)tok * DM + nt * 128 + wn * 64 + 8 * hi;
#pragma unroll
            for (int j = 0; j < 2; ++j)
#pragma unroll
                for (int q = 0; q < 2; ++q) {
                    float v[8];
#pragma unroll
                    for (int e = 0; e < 8; ++e) { v[e] = acc[i][j][8 * q + e]; ss += v[e] * v[e]; }
                    *(u32x4*)(d + 32 * j + 16 * q) = pack8(v);
                }
            ss = swap32_sum(ss);
            if (hi == 0) atomicAdd(ssq + tok, ss);
        }
    }
};

__device__ __forceinline__ void conv_phase(const Params& p, int gtid, int gthreads) {
    const bf16_t* cu = (const bf16_t*)(p.ws + WS_CU); const bf16_t* gz = (const bf16_t*)(p.ws + WS_GZ); bf16_t* mixa = (bf16_t*)(p.ws + WS_MIXA);
    for (int id = gtid; id < NTOK * 64; id += gthreads) {
        const int tok = id >> 6, c0 = (id & 63) * 8, pos = tok_pos(tok), S = tok < NTOK_P ? SEQ_P : SEQ_S;
        const u32x4 z4 = {0u, 0u, 0u, 0u};
        const u32x4 cm = *(const u32x4*)(cu + (size_t)tok * CW + c0);
        const u32x4 cl = pos > 0 ? *(const u32x4*)(cu + (size_t)(tok - 1) * CW + c0) : z4;
        const u32x4 cr = pos < S - 1 ? *(const u32x4*)(cu + (size_t)(tok + 1) * CW + c0) : z4;
        const u32x4 g = *(const u32x4*)(gz + (size_t)tok * CW + c0);
        float w0[8], w1[8], w2[8], o[8];
#pragma unroll
        for (int e = 0; e < 8; ++e) { w0[e] = p.conv_w[c0 + e]; w1[e] = p.conv_w[CW + c0 + e]; w2[e] = p.conv_w[2 * CW + c0 + e]; }
#pragma unroll
        for (int e = 0; e < 4; ++e) {
            o[2 * e] = bf_lo(g[e]) * (w0[2 * e] * bf_lo(cl[e]) + w1[2 * e] * bf_lo(cm[e]) + w2[2 * e] * bf_lo(cr[e]));
            o[2 * e + 1] = bf_hi(g[e]) * (w0[2 * e + 1] * bf_hi(cl[e]) + w1[2 * e + 1] * bf_hi(cm[e]) + w2[2 * e + 1] * bf_hi(cr[e]));
        }
        *(u32x4*)(mixa + (size_t)tok * CW + c0) = pack8(o);
    }
}

constexpr int AT_STAGE = 40960, AT_NSLOT = 3;
static_assert(AT_NSLOT * AT_STAGE <= LDS_BYTES, "attention ring");
__device__ __forceinline__ float max3f(float a, float b, float c) { float r; asm("v_max3_f32 %0, %1, %2, %3" : "=v"(r) : "v"(a), "v"(b), "v"(c)); return r; }
__device__ __forceinline__ float max2f_pad(float a, float b) { float r; asm("v_max_f32_e32 %0, %1, %2\n\ts_nop 1" : "=v"(r) : "v"(a), "v"(b)); return r; }
#define AT_PIN(x) asm volatile("" : "+v"(x))
__device__ __forceinline__ void attn_dma(unsigned lds0, int slot, srd_t srdK, srd_t srdV, unsigned koff, unsigned voffs, int wid, int lane) {
#pragma unroll
    for (int it = 0; it < 5; ++it) {
        const int pc = wid + 8 * it;
        const unsigned m0v = rflu(lds0 + (unsigned)(slot * AT_STAGE + pc * 1024));
        if (it < 3) bdma16(m0v, (unsigned)lane * 16u, srdK, rflu(koff + (unsigned)pc * 1024u));
        else bdma16(m0v, (unsigned)lane * 16u, srdV, rflu(voffs + (unsigned)(pc - 24) * 1024u));
    }
}
__device__ __forceinline__ void attn_unit(unsigned char* lds, const Params& p, int head, int tok0, int S, int qblk) {
    const int tid = threadIdx.x, lane = tid & 63, wid = __builtin_amdgcn_readfirstlane(tid >> 6), r32 = lane & 31, hi = lane >> 5;
    const unsigned lds0 = rflu((unsigned)(uintptr_t)lds);
    const int tq0 = tok0 + qblk * 256 + wid * 32;
    const srd_t srdK = make_srd(p.ws + WS_KF), srdV = make_srd(p.ws + WS_VF);
    const unsigned koff0 = (unsigned)(head * NBLK32 + (tok0 >> 5)) * 3072u;
    const unsigned voff0 = (unsigned)(head * (NTOK / 64) + (tok0 >> 6)) * 4096u;
    const int NU = S / 256;
    attn_dma(lds0, 0, srdK, srdV, koff0, voff0, wid, lane);
    attn_dma(lds0, 1, srdK, srdV, koff0 + 24576u, voff0 + 16384u, wid, lane);
    u32x4 q0, q1, q2;
    { const unsigned char* qp = p.ws + WS_QF + (size_t)(head * NBLK32 + (tq0 >> 5)) * 3072 + lane * 16;
      q0 = *(const u32x4*)qp; q1 = *(const u32x4*)(qp + 1024); q2 = *(const u32x4*)(qp + 2048); }
    i32x8 Q01 = {(int)q0.x, (int)q0.y, (int)q0.z, (int)q0.w, (int)q1.x, (int)q1.y, (int)q1.z, (int)q1.w};
    i32x8 Q2Z = {(int)q2.x, (int)q2.y, (int)q2.z, (int)q2.w, 0, 0, 0, 0};
    asm volatile("" : "+v"(Q01), "+v"(Q2Z));
    i32x8 PP = {0, 0, 0, 0, 0, 0, 0, 0};
    f32x16 o0, o1, negm;
#pragma unroll
    for (int r = 0; r < 16; ++r) { o0[r] = 0.f; o1[r] = 0.f; negm[r] = 0.f; }
    AT_PIN(negm);
    float mref = 0.f, l0 = 0.f, l1 = 0.f;
    AT_WAIT_BAR(5);
    int slot = 0;
    for (int u = 0; u < NU; ++u) {
        const bool pf = u + 2 < NU;
        const int s2 = slot == 0 ? 2 : slot - 1;
#pragma unroll
        for (int g = 0; g < 2; ++g) {
            if (pf && (wid & 1) == g) attn_dma(lds0, s2, srdK, srdV, koff0 + (unsigned)(u + 2) * 24576u, voff0 + (unsigned)(u + 2) * 16384u, wid, lane);
            const unsigned char* kb = lds + slot * AT_STAGE + g * 12288 + lane * 16;
            const unsigned char* vb = lds + slot * AT_STAGE + 24576 + g * 8192 + lane * 16;
            f32x16 x0, x1, y0, y1;
            { const u32x4 a0 = *(const u32x4*)(kb), a1 = *(const u32x4*)(kb + 1024), a2 = *(const u32x4*)(kb + 2048);
              const u32x4 b0 = *(const u32x4*)(kb + 3072), b1 = *(const u32x4*)(kb + 4096), b2 = *(const u32x4*)(kb + 5120);
              i32x8 KA = {(int)a0.x, (int)a0.y, (int)a0.z, (int)a0.w, (int)a1.x, (int)a1.y, (int)a1.z, (int)a1.w};
              i32x8 KB = {(int)b0.x, (int)b0.y, (int)b0.z, (int)b0.w, (int)b1.x, (int)b1.y, (int)b1.z, (int)b1.w};
              x0 = mfma8v(KA, Q01, negm); x1 = mfma8v(KB, Q01, negm);
              KA[0] = (int)a2.x; KA[1] = (int)a2.y; KA[2] = (int)a2.z; KA[3] = (int)a2.w;
              KB[0] = (int)b2.x; KB[1] = (int)b2.y; KB[2] = (int)b2.z; KB[3] = (int)b2.w;
              x0 = mfma8v(KA, Q2Z, x0); x1 = mfma8v(KB, Q2Z, x1); }
            __builtin_amdgcn_sched_barrier(0);
            { const u32x4 c0 = *(const u32x4*)(kb + 6144), c1 = *(const u32x4*)(kb + 7168), c2 = *(const u32x4*)(kb + 8192);
              const u32x4 d0 = *(const u32x4*)(kb + 9216), d1 = *(const u32x4*)(kb + 10240), d2 = *(const u32x4*)(kb + 11264);
              i32x8 KC = {(int)c0.x, (int)c0.y, (int)c0.z, (int)c0.w, (int)c1.x, (int)c1.y, (int)c1.z, (int)c1.w};
              i32x8 KD = {(int)d0.x, (int)d0.y, (int)d0.z, (int)d0.w, (int)d1.x, (int)d1.y, (int)d1.z, (int)d1.w};
              y0 = mfma8v(KC, Q01, negm); y1 = mfma8v(KD, Q01, negm);
              KC[0] = (int)c2.x; KC[1] = (int)c2.y; KC[2] = (int)c2.z; KC[3] = (int)c2.w;
              KD[0] = (int)d2.x; KD[1] = (int)d2.y; KD[2] = (int)d2.z; KD[3] = (int)d2.w;
              y0 = mfma8v(KC, Q2Z, y0); y1 = mfma8v(KD, Q2Z, y1); }
            asm volatile("s_nop 15\n\ts_nop 15" : "+v"(x0), "+v"(x1), "+v"(y0), "+v"(y1));
            float ma = max3f(x0[0], x0[1], x1[0]), mb = max3f(x0[2], x0[3], x1[1]); ma = max3f(ma, x1[2], x1[3]);
            float mc = max3f(y0[0], y0[1], y1[0]), md = max3f(y0[2], y0[3], y1[1]); mc = max3f(mc, y1[2], y1[3]);
#pragma unroll
            for (int r = 4; r < 16; r += 4) {
                ma = max3f(ma, x0[r], x0[r + 1]); mb = max3f(mb, x0[r + 2], x0[r + 3]); mc = max3f(mc, y0[r], y0[r + 1]); md = max3f(md, y0[r + 2], y0[r + 3]);
                ma = max3f(ma, x1[r], x1[r + 1]); mb = max3f(mb, x1[r + 2], x1[r + 3]); mc = max3f(mc, y1[r], y1[r + 1]); md = max3f(md, y1[r + 2], y1[r + 3]);
            }
            float mx = max2f_pad(max3f(ma, mb, mc), md);
            { auto rr = __builtin_amdgcn_permlane32_swap(__float_as_uint(mx), __float_as_uint(mx), false, false); mx = fmaxf(__uint_as_float(rr[0]), __uint_as_float(rr[1])); }
            const bool first = (u == 0) && (g == 0);
            if (__builtin_expect(first || __any(mx > 7.5f), 0)) {
                const float d = first ? mx - 6.f : fmaxf(mx - 6.f, 0.f);
                mref += d;
                const float f = __builtin_amdgcn_exp2f(-d);
#pragma unroll
                for (int r = 0; r < 16; ++r) { x0[r] -= d; x1[r] -= d; y0[r] -= d; y1[r] -= d; o0[r] *= f; o1[r] *= f; negm[r] = -mref; }
                l0 *= f; l1 *= f;
                AT_PIN(negm);
            }
#pragma unroll
            for (int r = 0; r < 16; ++r) { x0[r] = __builtin_amdgcn_exp2f(x0[r]); x1[r] = __builtin_amdgcn_exp2f(x1[r]); }
#pragma unroll
            for (int r = 0; r < 16; ++r) { l0 += x0[r]; AT_PIN(l0); l1 += x1[r]; AT_PIN(l1); }
            pack32_fp8_into(PP, x0, x1);
            { const u32x4 v00 = *(const u32x4*)(vb), v01 = *(const u32x4*)(vb + 1024), v10 = *(const u32x4*)(vb + 2048), v11 = *(const u32x4*)(vb + 3072);
              const i32x8 V0 = {(int)v00.x, (int)v00.y, (int)v00.z, (int)v00.w, (int)v01.x, (int)v01.y, (int)v01.z, (int)v01.w};
              const i32x8 V1 = {(int)v10.x, (int)v10.y, (int)v10.z, (int)v10.w, (int)v11.x, (int)v11.y, (int)v11.z, (int)v11.w};
              o0 = mfma8v(V0, PP, o0); o1 = mfma8v(V1, PP, o1); }
#pragma unroll
            for (int r = 0; r < 16; ++r) { y0[r] = __builtin_amdgcn_exp2f(y0[r]); y1[r] = __builtin_amdgcn_exp2f(y1[r]); }
#pragma unroll
            for (int r = 0; r < 16; ++r) { l0 += y0[r]; AT_PIN(l0); l1 += y1[r]; AT_PIN(l1); }
            pack32_fp8_into(PP, y0, y1);
            { const u32x4 v00 = *(const u32x4*)(vb + 4096), v01 = *(const u32x4*)(vb + 5120), v10 = *(const u32x4*)(vb + 6144), v11 = *(const u32x4*)(vb + 7168);
              const i32x8 V0 = {(int)v00.x, (int)v00.y, (int)v00.z, (int)v00.w, (int)v01.x, (int)v01.y, (int)v01.z, (int)v01.w};
              const i32x8 V1 = {(int)v10.x, (int)v10.y, (int)v10.z, (int)v10.w, (int)v11.x, (int)v11.y, (int)v11.z, (int)v11.w};
              o0 = mfma8v(V0, PP, o0); o1 = mfma8v(V1, PP, o1); }
        }
        if (pf) AT_WAIT_BAR(5); else AT_WAIT_BAR(0);
        slot = slot == 2 ? 0 : slot + 1;
    }
    const float inv = 1.f / swap32_sum(l0 + l1);
    const int tok = tq0 + r32;
    const bf16_t* sz = (const bf16_t*)(p.ws + WS_SZ) + (size_t)tok * AW + head * 64 + 8 * hi;
    bf16_t* mo = (bf16_t*)(p.ws + WS_MIX2) + (size_t)tok * AW + head * 64 + 8 * hi;
#pragma unroll
    for (int d0 = 0; d0 < 2; ++d0)
#pragma unroll
        for (int q8 = 0; q8 < 2; ++q8) {
            const u32x4 g = *(const u32x4*)(sz + 32 * d0 + 16 * q8);
            float v[8];
#pragma unroll
            for (int e = 0; e < 4; ++e) {
                const float a = d0 == 0 ? o0[8 * q8 + 2 * e] : o1[8 * q8 + 2 * e], b = d0 == 0 ? o0[8 * q8 + 2 * e + 1] : o1[8 * q8 + 2 * e + 1];
                v[2 * e] = a * inv * bf_lo(g[e]); v[2 * e + 1] = b * inv * bf_hi(g[e]);
            }
            *(u32x4*)(mo + 32 * d0 + 16 * q8) = pack8(v);
        }
}


constexpr size_t WS_BAR = 640 * 1024;
#define XB_TMO      128
#define XB_XCNT(j)  (256  + 64 * (j))
#define XB_XSUB(j)  (1280 + 64 * (j))
#define XB_XGEN(j)  (2304 + 64 * (j))
#define XB_TOP      3328
#define XB_TOPGEN   3392
#define XCD_BAR_WORDS 3456
#define XB_SPIN_CAP (1u << 18)
__device__ __forceinline__ unsigned xb_ld(unsigned* p)              { return __hip_atomic_load(p, __ATOMIC_RELAXED, __HIP_MEMORY_SCOPE_AGENT); }
__device__ __forceinline__ unsigned xb_add(unsigned* p, unsigned v) { return __hip_atomic_fetch_add(p, v, __ATOMIC_RELAXED, __HIP_MEMORY_SCOPE_AGENT); }
__device__ __forceinline__ unsigned xb_xcc_id() { return (unsigned)__builtin_amdgcn_s_getreg((3 << 11) | 20) & 0xFu; }
#define XB_SPIN(cond, bar) do { unsigned _sp = 0; while (cond) { __builtin_amdgcn_s_sleep(1); \
    if ((++_sp & 255u) == 0u) { if (xb_ld(&(bar)[XB_TMO])) break; if (_sp > XB_SPIN_CAP) { atomicAdd(&(bar)[XB_TMO], 1u); break; } } } } while (0)
struct XcdBarrier { unsigned* bar; unsigned x; unsigned nloc, nx; };
__device__ __forceinline__ XcdBarrier xcd_barrier_post(unsigned* bar) {
    XcdBarrier b; b.bar = bar; b.x = xb_xcc_id(); b.nloc = 0u; b.nx = 0u;
    if (threadIdx.x == 0) (void)xb_add(&bar[XB_XCNT(b.x)], 1u);
    return b;
}
__device__ __forceinline__ void xcd_barrier_complete(unsigned* bar, unsigned x, unsigned& nloc, unsigned& nx) {
    const unsigned G = gridDim.x * gridDim.y * gridDim.z;
    unsigned sum, cnt, mine, sp = 0u;
    for (;;) {
        sum = 0u; cnt = 0u; mine = 0u;
#pragma unroll
        for (unsigned j = 0; j < 16; ++j) { const unsigned c = xb_ld(&bar[XB_XCNT(j)]); sum += c; cnt += (c > 0u) ? 1u : 0u; mine = (j == x) ? c : mine; }
        if (sum == G) break;
        __builtin_amdgcn_s_sleep(1);
        if ((++sp & 255u) == 0u) { if (xb_ld(&bar[XB_TMO])) break; if (sp > XB_SPIN_CAP) { atomicAdd(&bar[XB_TMO], 1u); break; } }
    }
    nloc = mine > 0u ? mine : 1u; nx = cnt > 0u ? cnt : 1u;
}
__device__ __forceinline__ void xcd_barrier(XcdBarrier& b) {
    asm volatile("s_waitcnt vmcnt(0)" ::: "memory");
    __syncthreads();
    if (threadIdx.x == 0) {
        unsigned* bar = b.bar;
        __builtin_amdgcn_s_waitcnt(0);
        unsigned nloc = b.nloc, nx = b.nx;
        if (nloc == 0u) { xcd_barrier_complete(bar, b.x, nloc, nx); b.nloc = nloc; b.nx = nx; }
        const unsigned old = xb_add(&bar[XB_XSUB(b.x)], 1u);
        const unsigned gen = old / nloc;
        if (old + 1u == (gen + 1u) * nloc) {
            __builtin_amdgcn_fence(__ATOMIC_RELEASE, "agent");
            asm volatile("s_waitcnt vmcnt(0)" ::: "memory");
            const unsigned og = xb_add(&bar[XB_TOP], 1u);
            const unsigned tg = og / nx;
            if (og + 1u == (tg + 1u) * nx) xb_add(&bar[XB_TOPGEN], 1u);
            else XB_SPIN(xb_ld(&bar[XB_TOPGEN]) == tg, bar);
            __builtin_amdgcn_fence(__ATOMIC_ACQUIRE, "agent");
            xb_add(&bar[XB_XGEN(b.x)], 1u);
            asm volatile("s_waitcnt vmcnt(0)" ::: "memory");
        } else {
            XB_SPIN(xb_ld(&bar[XB_XGEN(b.x)]) == gen, bar);
            __builtin_amdgcn_fence(__ATOMIC_ACQUIRE, "agent");
            asm volatile("s_waitcnt vmcnt(0)" ::: "memory");
        }
    }
    __syncthreads();
}

__global__ void __launch_bounds__(NTHR, 2) fwd_kernel(Params p) {
    extern __shared__ __attribute__((aligned(16))) unsigned char lds[];
    cg::grid_group grid = cg::this_grid();
    const int G = gridDim.x, bx = blockIdx.x, tid = threadIdx.x;
    const int gtid = bx * NTHR + tid, gthreads = G * NTHR;
    const int xcd = bx & 7, lb = bx >> 3, GX = G >> 3;
    unsigned char* ws = p.ws;

    __syncthreads();
    XcdBarrier xbar = xcd_barrier_post((unsigned*)(ws + WS_BAR));
    if (p.ws == nullptr) grid.sync();
    phase0(p, gtid, gthreads);
    xcd_barrier(xbar);

    { EpiIn E{ws}; const bf16_t* xn = (const bf16_t*)(ws + WS_XN); const bf16_t* W = (const bf16_t*)(ws + WS_WIN);
      gemm_dma<4, 2, 0>(lds, xn, xn, 1 << 30, DM, W, DM, 13, xcd, lb, GX, E); }
    xcd_barrier(xbar);

    { EpiQ E{ws}; const bf16_t* A = (const bf16_t*)(ws + WS_QLAT); const bf16_t* W = (const bf16_t*)(ws + WS_WUQ);
      gemm_dma<2, 3, 0>(lds, A, A, 1 << 30, QLR, W, QLR, 2, xcd, lb, GX, E); }
    { EpiKV E{ws}; const bf16_t* A = (const bf16_t*)(ws + WS_KVLAT); const bf16_t* W = (const bf16_t*)(ws + WS_WUKV);
      gemm_dma<4, 2, 1>(lds, A, A, 1 << 30, KVLR, W, KVLR, 4, xcd, lb, GX, E); }
    xcd_barrier(xbar);

    for (int w = lb; w < 128; w += GX) { const int bl = w >> 6, qblk = w & 63; attn_unit(lds, p, xcd, NTOK_P + bl * SEQ_S, SEQ_S, qblk); }
    { unsigned* tick = (unsigned*)(ws + WS_BAR) + 3584 + 64 * xcd;
      for (;;) {
          if (tid == 0) *(volatile unsigned*)lds = xb_add(tick, 1u);
          __syncthreads();
          const unsigned w2 = *(volatile unsigned*)lds;
          __syncthreads();
          if (w2 >= 64u) break;
          attn_unit(lds, p, (int)(w2 >> 3), xcd * SEQ_P, SEQ_P, (int)(w2 & 7));
      } }
    conv_phase(p, gtid, gthreads);
    xcd_barrier(xbar);

    { EpiOut E{ws}; const bf16_t* A0 = (const bf16_t*)(ws + WS_MIXA); const bf16_t* A1 = (const bf16_t*)(ws + WS_MIX2); const bf16_t* W = (const bf16_t*)(ws + WS_WOUT);
      gemm_dma<4, 2, 0>(lds, A0, A1, 512, CW, W, DM, 4, xcd, lb, GX, E); }
    xcd_barrier(xbar);

    { const float* ssq = (const float*)(ws + WS_SSQ) + 2 * NTOK; const bf16_t* ob = (const bf16_t*)(ws + WS_XN);
      const int lane = tid & 63, gw = gtid >> 6, nw = gthreads >> 6;
      f32x4 g[4];
#pragma unroll
      for (int j = 0; j < 4; ++j) g[j] = *(const f32x4*)(p.norm_post + 4 * lane + 256 * j);
      for (int row = gw * 4; row < NTOK; row += nw * 4) {
          f32x4 xv[4][4]; u32x2 ov[4][4]; float rs[4];
#pragma unroll
          for (int u = 0; u < 4; ++u) {
              const float* xr = xrow(p, row + u) + 4 * lane; const bf16_t* orow = ob + (size_t)(row + u) * DM + 4 * lane;
#pragma unroll
              for (int j = 0; j < 4; ++j) { xv[u][j] = __builtin_nontemporal_load((const f32x4*)(xr + 256 * j)); ov[u][j] = __builtin_nontemporal_load((const u32x2*)(orow + 256 * j)); }
              rs[u] = rsqrtf(ssq[row + u] * (1.f / DM) + EPS);
          }
#pragma unroll
          for (int u = 0; u < 4; ++u) {
              float* yr = p.out + (size_t)(row + u) * DM + 4 * lane;
#pragma unroll
              for (int j = 0; j < 4; ++j) {
                  f32x4 o; o.x = bf_lo(ov[u][j].x); o.y = bf_hi(ov[u][j].x); o.z = bf_lo(ov[u][j].y); o.w = bf_hi(ov[u][j].y);
                  __builtin_nontemporal_store(xv[u][j] + o * rs[u] * g[j], (f32x4*)(yr + 256 * j));
              }
          }
      } }
}

extern "C" void kernel_launch(void* const* d_in, const int* in_sizes, int n_in, void* d_out, int out_size, void* d_ws, size_t ws_size, hipStream_t stream) {
    static int grid_blocks = 0;
    if (!grid_blocks) {
        int dev = 0, cus = 0, per_cu = 0;
        hipGetDevice(&dev);
        hipDeviceGetAttribute(&cus, hipDeviceAttributeMultiprocessorCount, dev);
        hipFuncSetAttribute((const void*)fwd_kernel, hipFuncAttributeMaxDynamicSharedMemorySize, LDS_BYTES);
        hipOccupancyMaxActiveBlocksPerMultiprocessor(&per_cu, (const void*)fwd_kernel, NTHR, LDS_BYTES);
        if (per_cu < 1) per_cu = 1;
        if (per_cu > 1) per_cu = 1;
        grid_blocks = cus * per_cu;
        if (ws_size < WS_END) fprintf(stderr, "kernel_launch: workspace too small (%zu < %zu)\n", ws_size, (size_t)WS_END);
    }
    (void)hipMemsetAsync((unsigned char*)d_ws + WS_BAR, 0, 16384, stream);
    Params p{};
    p.x_prompt = (const float*)d_in[0]; p.x_sample = (const float*)d_in[1]; p.norm_pre = (const float*)d_in[2]; p.w_in = (const float*)d_in[3];
    p.conv_w = (const float*)d_in[4]; p.q_norm = (const float*)d_in[5]; p.w_uq = (const float*)d_in[6]; p.kv_norm = (const float*)d_in[7];
    p.w_ukv = (const float*)d_in[8]; p.w_out = (const float*)d_in[9]; p.norm_post = (const float*)d_in[10];
    p.out = (float*)d_out; p.ws = (unsigned char*)d_ws;
    void* args[] = {&p};
    hipError_t e = hipLaunchCooperativeKernel((const void*)fwd_kernel, dim3(grid_blocks), dim3(NTHR), args, LDS_BYTES, stream);
    if (e != hipSuccess) fprintf(stderr, "cooperative launch failed: %s (grid %d)\n", hipGetErrorString(e), grid_blocks);
}
```
